# Optimizing an MI355X kernel written in HIP

```python
import jax, jax.numpy as jnp
from jax import lax
import numpy as np

D_MODEL = 1024
BATCH = 8
SEQ = 4096
DEPTH = 2
DEC_BATCH = 16
DEC_SEQ = 4096
PAST_LEN = 128

N_MIXERS = 2
N_FGROUPS = 8
F_GROUP = D_MODEL // N_FGROUPS
HEAD_DIM = 128
N_HEADS = D_MODEL // HEAD_DIM
N_KV_HEADS = 2
KV_GROUP = N_HEADS // N_KV_HEADS
QKV_DIM = (N_HEADS + 2 * N_KV_HEADS) * HEAD_DIM
AXIS_DIM = HEAD_DIM // 2
ROPE_THETA = 10000.0
GRID_W = 64
Q_BLOCK = 128
D_FF = 4 * D_MODEL
EPS = 1e-6

kernel_name = "fourier_gqa_axial_hybrid_encoder"


def rms_norm(x, g):
    x32 = x.astype(jnp.float32)
    y = x32 * lax.rsqrt(jnp.mean(x32 * x32, axis=-1, keepdims=True) + EPS)
    return (y * g.astype(jnp.float32)).astype(x.dtype)


def fourier_mix(h, w_out):
    B, S, _ = h.shape
    hg = h.astype(jnp.float32).reshape(B, S, N_FGROUPS, F_GROUP)
    f = jnp.fft.fft2(hg, axes=(1, 3), norm="ortho").real
    f = f.reshape(B, S, D_MODEL).astype(h.dtype)
    return f @ w_out


def axial_angles(S):
    rows = S // GRID_W
    row = jnp.repeat(jnp.arange(rows, dtype=jnp.float32), GRID_W)
    col = jnp.tile(jnp.arange(GRID_W, dtype=jnp.float32), rows)
    inv = ROPE_THETA ** (-jnp.arange(0, AXIS_DIM, 2, dtype=jnp.float32) / AXIS_DIM)
    return row[:, None] * inv[None, :], col[:, None] * inv[None, :]


def rope_1d(x, ang):
    c = jnp.cos(ang)[:, None, :]
    s = jnp.sin(ang)[:, None, :]
    x1, x2 = jnp.split(x, 2, axis=-1)
    return jnp.concatenate([x1 * c - x2 * s, x2 * c + x1 * s], axis=-1)


def axial_rope(x, ang_row, ang_col):
    x32 = x.astype(jnp.float32)
    xr, xc = jnp.split(x32, 2, axis=-1)
    return jnp.concatenate([rope_1d(xr, ang_row), rope_1d(xc, ang_col)], axis=-1)


def gqa_attention(h, w_qkv, q_gain, k_gain, w_o):
    B, S, _ = h.shape
    qkv = h @ w_qkv
    q = qkv[..., : N_HEADS * HEAD_DIM].reshape(B, S, N_HEADS, HEAD_DIM)
    k = qkv[..., N_HEADS * HEAD_DIM:(N_HEADS + N_KV_HEADS) * HEAD_DIM].reshape(B, S, N_KV_HEADS, HEAD_DIM)
    v = qkv[..., (N_HEADS + N_KV_HEADS) * HEAD_DIM:].reshape(B, S, N_KV_HEADS, HEAD_DIM)
    q = rms_norm(q, q_gain)
    k = rms_norm(k, k_gain)
    ang_row, ang_col = axial_angles(S)
    q = axial_rope(q, ang_row, ang_col) * (HEAD_DIM ** -0.5)
    k = axial_rope(k, ang_row, ang_col)
    n_blk = S // Q_BLOCK
    qb = q.reshape(B, n_blk, Q_BLOCK, N_KV_HEADS, KV_GROUP, HEAD_DIM).transpose(1, 0, 2, 3, 4, 5)

    def one_block(q_blk):
        s = jnp.einsum("bqkgd,bskd->bkgqs", q_blk, k)
        p = jax.nn.softmax(s, axis=-1)
        return jnp.einsum("bkgqs,bskd->bqkgd", p.astype(v.dtype), v)

    o = lax.map(one_block, qb)
    o = o.transpose(1, 0, 2, 3, 4, 5).reshape(B, S, N_HEADS * HEAD_DIM).astype(h.dtype)
    return o @ w_o


def sq_relu_mlp(h, w_up, w_down):
    a = jnp.maximum(h @ w_up, 0)
    return (a * a) @ w_down


def trunk(x, fourier_norm, fourier_w_out, attn_norm, attn_w_qkv, attn_q_norm, attn_k_norm,
          attn_w_o, mlp_norm, mlp_w_up, mlp_w_down, final_norm):
    for i in range(DEPTH):
        j = i // N_MIXERS
        if i % N_MIXERS == 0:
            x = x + fourier_mix(rms_norm(x, fourier_norm[j]), fourier_w_out[j])
        else:
            x = x + gqa_attention(rms_norm(x, attn_norm[j]), attn_w_qkv[j], attn_q_norm[j],
                                  attn_k_norm[j], attn_w_o[j])
        x = x + sq_relu_mlp(rms_norm(x, mlp_norm[i]), mlp_w_up[i], mlp_w_down[i])
    return rms_norm(x, final_norm)


def setup_inputs(seed: int = 0) -> dict:
    key = jax.random.key(seed)
    ks = jax.random.split(key, 16)
    n_a = (DEPTH + N_MIXERS - 1) // N_MIXERS
    n_b = DEPTH // N_MIXERS
    f32 = jnp.float32

    def w(k, shape, fan_in):
        return jax.random.normal(k, shape, f32) * (fan_in ** -0.5)

    def gain(k, shape):
        return 1.0 + 0.02 * jax.random.normal(k, shape, f32)

    return {
        "x_prompt": jax.random.normal(ks[0], (BATCH, SEQ, D_MODEL), f32),
        "x_sample": jax.random.normal(ks[1], (DEC_BATCH, DEC_SEQ, D_MODEL), f32),
        "fourier_norm": gain(ks[2], (n_a, D_MODEL)),
        "fourier_w_out": w(ks[3], (n_a, D_MODEL, D_MODEL), D_MODEL),
        "attn_norm": gain(ks[4], (n_b, D_MODEL)),
        "attn_w_qkv": w(ks[5], (n_b, D_MODEL, QKV_DIM), D_MODEL),
        "attn_q_norm": gain(ks[6], (n_b, HEAD_DIM)),
        "attn_k_norm": gain(ks[7], (n_b, HEAD_DIM)),
        "attn_w_o": w(ks[8], (n_b, N_HEADS * HEAD_DIM, D_MODEL), N_HEADS * HEAD_DIM),
        "mlp_norm": gain(ks[9], (DEPTH, D_MODEL)),
        "mlp_w_up": w(ks[10], (DEPTH, D_MODEL, D_FF), D_MODEL),
        "mlp_w_down": w(ks[11], (DEPTH, D_FF, D_MODEL), D_FF),
        "final_norm": gain(ks[12], (D_MODEL,)),
    }


def reference(x_prompt, x_sample, fourier_norm, fourier_w_out, attn_norm, attn_w_qkv, attn_q_norm,
              attn_k_norm, attn_w_o, mlp_norm, mlp_w_up, mlp_w_down, final_norm):
    y_prompt = trunk(x_prompt, fourier_norm, fourier_w_out, attn_norm, attn_w_qkv, attn_q_norm,
                     attn_k_norm, attn_w_o, mlp_norm, mlp_w_up, mlp_w_down, final_norm)
    y_sample = trunk(x_sample, fourier_norm, fourier_w_out, attn_norm, attn_w_qkv, attn_q_norm,
                     attn_k_norm, attn_w_o, mlp_norm, mlp_w_up, mlp_w_down, final_norm)
    return (y_prompt, y_sample)
```

```cpp
#include <hip/hip_runtime.h>
#include <hip/hip_bf16.h>
#include <hip/hip_cooperative_groups.h>
#include <cstdio>
#include <cstdint>
namespace cg = cooperative_groups;

#ifndef MK_PER_PHASE
#define MK_PER_PHASE 0
#endif

constexpr int D = 1024, SEQ = 4096, NBATCH = 24, T = NBATCH * SEQ;
constexpr int T_PROMPT = 8 * SEQ;
constexpr int FF = 4096, QKVD = 1536;
constexpr float EPS = 1e-6f;

#ifndef PG8_ALIGN
#define PG8_ALIGN 1
#endif
#ifndef PG8_SP2
#define PG8_SP2 1
#endif
namespace pg8 {
#define PG8_LAS __attribute__((address_space(3)))
typedef unsigned short bf16_t;
typedef short bf16x8 __attribute__((ext_vector_type(8)));
typedef float f32x4 __attribute__((ext_vector_type(4)));
typedef unsigned u32x4 __attribute__((ext_vector_type(4)));
constexpr int BM = 256, BK = 64, HALF = 128, HTB = HALF * BK * 2, STAGE_BYTES = 8 * HTB, NXCD = 8, WGM = 8;

__host__ __device__ __forceinline__ int lds_byte(int r, int c) { const int st = (r >> 4) * 2 + (c >> 5), rr = r & 15, cc = c & 31, ob = rr * 64 + cc * 2; return st * 1024 + (ob ^ (((ob >> 9) & 1) << 5)); }
__host__ __device__ __forceinline__ void stage_rc(int b, int& R, int& C) { const int st = b / 1024, sb = b % 1024, swz = sb ^ (((sb >> 9) & 1) << 5); R = (st >> 1) * 16 + swz / 64; C = (st & 1) * 32 + (swz % 64) / 2; }
__host__ __device__ __forceinline__ int perm32(int rho) { const int n = rho >> 4, i = rho & 15; return 8 * (i >> 2) + 4 * n + (i & 3); }

struct Unit { int pm, pn; const char* a; const char* b; size_t c; };
struct Gemm { int K, lda, ldb; unsigned hsA, hsB; int amask, bmode; int skip; };
__device__ __forceinline__ Gemm plain(int K, int lda, int ldb) { return Gemm{K, lda, ldb, (unsigned)(HALF * lda * 2), (unsigned)(HALF * ldb * 2), 127, 0, 0}; }

__device__ __forceinline__ bool tile_decode(int i, int G, int c, int nM, int nN, int& pm, int& pn) {
    const int nwg = nM * nN; const long L = (long)i * G + c; if (L >= nwg) return false;
    int wgid = (int)L; { const int q = nwg / NXCD, r = nwg % NXCD, xcd = wgid % NXCD, off = wgid / NXCD; wgid = (xcd < r ? xcd * (q + 1) : r * (q + 1) + (xcd - r) * q) + off; }
    const int nig = WGM * nN, gid = wgid / nig, fm = gid * WGM, gsz = (nM - fm) < WGM ? (nM - fm) : WGM;
    pm = fm + ((wgid % nig) % gsz); pn = (wgid % nig) / gsz; return true;
}
struct SchedMN {
    const char* A; const char* B; int nM, nN, G, c; size_t a_tile, b_tile; int ldc;
    __device__ __forceinline__ bool next(int i, Unit& u) const {
        if (!tile_decode(i, G, c, nM, nN, u.pm, u.pn)) return false;
        u.a = A + (size_t)u.pm * a_tile; u.b = B + (size_t)u.pn * b_tile; u.c = (size_t)u.pm * BM * ldc + (size_t)u.pn * BM; return true;
    }
};
struct SchedChan {
    const char* A; const char* B; int G, c;
    __device__ __forceinline__ bool next(int i, Unit& u) const {
        if (!tile_decode(i, G, c, NBATCH * 8, SEQ / BM, u.pm, u.pn)) return false;
        u.a = A; u.b = B + (((size_t)(u.pm >> 3) * SEQ + (size_t)u.pn * 4) * D + (size_t)(u.pm & 7) * 128) * 2; u.c = 0; return true;
    }
};
struct SchedLin {
    const char* A; const char* B; int G, c; int nN; int a_shift; size_t a_stride;
    __device__ __forceinline__ bool next(int i, Unit& u) const {
        if (!tile_decode(i, G, c, 1, nN, u.pm, u.pn)) return false;
        u.a = a_shift ? A + (size_t)((u.pn >> 2) & 63) * a_stride : A; u.b = B + (size_t)u.pn * BM * 128 * 2; u.c = 0; return true;
    }
};

__device__ __forceinline__ unsigned cvt_pk_bf16(float lo, float hi) { unsigned r; asm volatile("v_cvt_pk_bf16_f32 %0, %1, %2" : "=v"(r) : "v"(lo), "v"(hi)); return r; }

template <int ACT  > struct EpiBf16 {
    static constexpr bool PERM = true;
    bf16_t* O; int ldc; const float* ssq;
    struct Pre { float v[2][4]; };
    __device__ __forceinline__ Pre prefetch(const Unit& u, int wr, int fr) const {
        Pre p;
#pragma unroll
        for (int ai = 0; ai < 2; ++ai)
#pragma unroll
            for (int m = 0; m < 4; ++m) p.v[ai][m] = ssq ? ssq[u.pm * BM + wr * 64 + fr + ai * HALF + m * 16] : 0.f;
        return p;
    }
    __device__ __forceinline__ void operator()(const f32x4 (&acc)[2][2][4][2], const Unit& u, int wr, int wc, int fr, int fq, const Pre& pre) const {
        bf16_t* base = O + u.c + (size_t)(wr * 64 + fr) * ldc + wc * 32 + 8 * fq;
        float rs[2][4];
#pragma unroll
        for (int ai = 0; ai < 2; ++ai)
#pragma unroll
            for (int m = 0; m < 4; ++m) rs[ai][m] = ssq ? 1.0f / sqrtf(pre.v[ai][m] * (1.0f / 1024.0f) + 1e-6f) : 1.0f;
#pragma unroll
        for (int ai = 0; ai < 2; ++ai)
#pragma unroll
            for (int m = 0; m < 4; ++m) { bf16_t* rowp = base + (size_t)(ai * HALF + m * 16) * ldc;
#pragma unroll
                for (int bj = 0; bj < 2; ++bj) { f32x4 v0 = acc[ai][bj][m][0] * rs[ai][m], v1 = acc[ai][bj][m][1] * rs[ai][m];
                    if (ACT == 2) {
#pragma unroll
                        for (int e = 0; e < 4; ++e) { const float a0 = fmaxf(v0[e], 0.f), a1 = fmaxf(v1[e], 0.f); v0[e] = a0 * a0; v1[e] = a1 * a1; } }
                    u32x4 w; w.x = cvt_pk_bf16(v0[0], v0[1]); w.y = cvt_pk_bf16(v0[2], v0[3]); w.z = cvt_pk_bf16(v1[0], v1[1]); w.w = cvt_pk_bf16(v1[2], v1[3]);
                    *(u32x4*)(rowp + bj * HALF) = w; } }
    }
};
struct EpiRes {
    static constexpr bool PERM = false;
    struct Pre {}; __device__ __forceinline__ Pre prefetch(const Unit&, int, int) const { return Pre{}; }
    const float* res0; const float* res1; int split_pm; size_t split_off;
    bf16_t* xs; float* ssq; int ldc;
    __device__ __forceinline__ void operator()(const f32x4 (&acc)[2][2][4][2], const Unit& u, int wr, int wc, int fr, int fq, const Pre&) const {
        typedef unsigned u32x2 __attribute__((ext_vector_type(2)));
        const float* rb = res0 ? ((u.pm < split_pm) ? res0 + u.c : res1 + (u.c - split_off)) : nullptr;
        bf16_t* xbt = xs + u.c; float* sqt = ssq + u.pm * BM;
        unsigned off0 = (unsigned)((wr * 64 + fr) * ldc + wc * 32 + 4 * fq), roff = (unsigned)(wr * 64 + fr);
        asm volatile("" : "+v"(off0), "+v"(roff));
#pragma unroll
        for (int am = 0; am < 4; ++am) { const int ai = am >> 1, mb = (am & 1) * 2;
            f32x4 rr[4][2][2];
#pragma unroll
            for (int m = mb; m < mb + 2; ++m)
#pragma unroll
                for (int bj = 0; bj < 2; ++bj)
#pragma unroll
                    for (int n = 0; n < 2; ++n) { const unsigned o = off0 + (unsigned)((ai * HALF + m * 16) * ldc) + bj * HALF + n * 16;
                        if (res0) rr[m][bj][n] = *(const f32x4*)(rb + o);
                        else { const u32x2 w = *(const u32x2*)(xbt + o); rr[m][bj][n] = (f32x4){__builtin_bit_cast(float, w.x << 16), __builtin_bit_cast(float, w.x & 0xffff0000u), __builtin_bit_cast(float, w.y << 16), __builtin_bit_cast(float, w.y & 0xffff0000u)}; } }
            asm volatile("" ::: "memory");
#pragma unroll
            for (int m = mb; m < mb + 2; ++m) { const unsigned off = off0 + (unsigned)((ai * HALF + m * 16) * ldc); float sq = 0.f;
#pragma unroll
                for (int bj = 0; bj < 2; ++bj) {
                    const unsigned o0 = off + bj * HALF, o1 = o0 + 16;
                    const f32x4 x0 = rr[m][bj][0] + acc[ai][bj][m][0], x1 = rr[m][bj][1] + acc[ai][bj][m][1];
                    sq += ((x0[0] * x0[0] + x0[1] * x0[1]) + (x0[2] * x0[2] + x0[3] * x0[3])) + ((x1[0] * x1[0] + x1[1] * x1[1]) + (x1[2] * x1[2] + x1[3] * x1[3]));
                    u32x2 w0, w1; w0.x = cvt_pk_bf16(x0[0], x0[1]); w0.y = cvt_pk_bf16(x0[2], x0[3]); w1.x = cvt_pk_bf16(x1[0], x1[1]); w1.y = cvt_pk_bf16(x1[2], x1[3]);
                    *(u32x2*)(xbt + o0) = w0; *(u32x2*)(xbt + o1) = w1; }
                sq += __shfl_xor(sq, 16); sq += __shfl_xor(sq, 32); if (fq == 0) atomicAdd(sqt + roff + (unsigned)(ai * HALF + m * 16), sq); }
            asm volatile("" ::: "memory"); }
    }
};
__device__ __forceinline__ void store8(bf16_t* p, const f32x4& v0, const f32x4& v1) {
    u32x4 w; w.x = cvt_pk_bf16(v0[0], v0[1]); w.y = cvt_pk_bf16(v0[2], v0[3]); w.z = cvt_pk_bf16(v1[0], v1[1]); w.w = cvt_pk_bf16(v1[2], v1[3]); *(u32x4*)p = w;
}
struct EpiChan {
    static constexpr bool PERM = true;
    struct Pre {}; __device__ __forceinline__ Pre prefetch(const Unit&, int, int) const { return Pre{}; }
    bf16_t* O;
    __device__ __forceinline__ void operator()(const f32x4 (&acc)[2][2][4][2], const Unit& u, int wr, int wc, int fr, int fq, const Pre&) const {
#pragma unroll
        for (int ai = 0; ai < 2; ++ai)
#pragma unroll
            for (int m = 0; m < 4; ++m) { const int r = ai * HALF + wr * 64 + m * 16 + fr, l = r >> 1, ri = r & 1;
#pragma unroll
                for (int bj = 0; bj < 2; ++bj) { const int nl = bj * HALF + wc * 32 + 8 * fq, s2 = 4 * u.pn + (nl >> 6), s1 = nl & 63;
                    store8(O + ((((size_t)u.pm * 128 + l) * 64 + s2) * 2 + ri) * 64 + s1, acc[ai][bj][m][0], acc[ai][bj][m][1]); } }
    }
};
struct EpiStageA {
    static constexpr bool PERM = true;
    struct Pre {}; __device__ __forceinline__ Pre prefetch(const Unit&, int, int) const { return Pre{}; }
    bf16_t* O;
    __device__ __forceinline__ void operator()(const f32x4 (&acc)[2][2][4][2], const Unit& u, int wr, int wc, int fr, int fq, const Pre&) const {
        const int z = u.pn >> 5, l0 = (u.pn & 31) * 4, b = z >> 3, g = z & 7;
#pragma unroll
        for (int m = 0; m < 4; ++m) { const int r = wr * 64 + m * 16 + fr, k1 = r >> 1, ro = r & 1;
#pragma unroll
            for (int bj = 0; bj < 2; ++bj) { const int nl = bj * HALF + wc * 32 + 8 * fq, l = l0 + (nl >> 6), s2 = nl & 63;
                store8(O + ((((size_t)(b * 64 + k1) * 8 + g) * 128 + l) * 2 + ro) * 64 + s2, acc[0][bj][m][0], acc[0][bj][m][1]); } }
    }
};
struct EpiStageB {
    static constexpr bool PERM = true;
    struct Pre {}; __device__ __forceinline__ Pre prefetch(const Unit&, int, int) const { return Pre{}; }
    bf16_t* O;
    __device__ __forceinline__ void operator()(const f32x4 (&acc)[2][2][4][2], const Unit& u, int wr, int wc, int fr, int fq, const Pre&) const {
        if (wr != 0) return;
        const int bk = u.pn >> 2, b = bk >> 6, k1 = bk & 63, ch0 = (u.pn & 3) * 256;
#pragma unroll
        for (int m = 0; m < 4; ++m) { const int k2 = m * 16 + fr;
#pragma unroll
            for (int bj = 0; bj < 2; ++bj) { const int nl = bj * HALF + wc * 32 + 8 * fq;
                store8(O + ((size_t)b * SEQ + k1 + 64 * k2) * D + ch0 + nl, acc[0][bj][m][0], acc[0][bj][m][1]); } }
    }
};

template <class Epi, class Sched>
__device__ __forceinline__ void gemm_phase(PG8_LAS unsigned char* lds, const Gemm g, const Sched& S, const Epi& E) {
    const int tid = threadIdx.x, wid = __builtin_amdgcn_readfirstlane(tid >> 6), lane = tid & 63, wr = wid >> 2, wc = wid & 3, fr = lane & 15, fq = lane >> 4;
    const int K = g.K, nt = K / BK;
    const bool do1 = (g.skip == 0), do0 = (g.skip < 2) || (wr == 0);
    unsigned voffA[2], voffB[2];
#pragma unroll
    for (int i = 0; i < 2; ++i) { int R, C; stage_rc(tid * 16 + i * 8192, R, C); const int Rb = Epi::PERM ? ((R & ~31) + perm32(R & 31)) : R;
        const int Rbm = g.bmode ? ((Rb & 63) * 64 + (Rb >> 6)) : Rb;
        voffA[i] = (unsigned)((R & g.amask) * g.lda + C) * 2u; voffB[i] = (unsigned)(Rbm * g.ldb + C) * 2u; }
    const size_t kstep = (size_t)(BK * 2);
    const size_t hstepA = g.hsA, hstepB = g.hsB;
    const unsigned ldsw = (unsigned)wid * 1024u;
    const int aoff = lds_byte(wr * 64 + fr, fq * 8), boff = lds_byte(wc * 32 + fr, fq * 8);
#define PG8_SA(b, h) (((b) * 2 + (h)) * HTB)
#define PG8_SB(b, h) ((4 + (b) * 2 + (h)) * HTB)
#define PG8_STAGE(bufoff, gbase, voff) do { _Pragma("unroll") for (int _i = 0; _i < 2; ++_i) \
        __builtin_amdgcn_global_load_lds((const unsigned*)((const char*)(gbase) + (voff)[_i]), (PG8_LAS unsigned*)(lds + (bufoff) + ldsw + _i * 8192), 16, 0, 0); } while (0)
#define PG8_LDA(dst, b, h) do { _Pragma("unroll") for (int m = 0; m < 4; ++m) _Pragma("unroll") for (int k = 0; k < 2; ++k) dst[m][k] = *(const PG8_LAS bf16x8*)(lds + PG8_SA(b, h) + aoff + m * 2048 + k * 1024); } while (0)
#define PG8_LDB(dst, b, h) do { _Pragma("unroll") for (int n = 0; n < 2; ++n) _Pragma("unroll") for (int k = 0; k < 2; ++k) dst[n][k] = *(const PG8_LAS bf16x8*)(lds + PG8_SB(b, h) + boff + n * 2048 + k * 1024); } while (0)
#define PG8_MMA(ai, bj, At, Bt) do { __builtin_amdgcn_s_setprio(1); _Pragma("unroll") for (int m = 0; m < 4; ++m) _Pragma("unroll") for (int n = 0; n < 2; ++n) _Pragma("unroll") for (int k = 0; k < 2; ++k) \
        acc[ai][bj][m][n] = __builtin_amdgcn_mfma_f32_16x16x32_bf16(Bt[n][k], At[m][k], acc[ai][bj][m][n], 0, 0, 0); __builtin_amdgcn_s_setprio(0); } while (0)
#define PG8_WAIT_V(n) asm volatile("s_waitcnt vmcnt(" #n ")" ::: "memory")
#define PG8_WAIT_L(n) asm volatile("s_waitcnt lgkmcnt(" #n ")" ::: "memory")
#define PG8_BAR __builtin_amdgcn_s_barrier()
#define PG8_SCHED __builtin_amdgcn_sched_barrier(0)
    Unit cur, nxt; int ui = 0;
    if (!S.next(0, cur)) return;
    f32x4 acc[2][2][4][2];
#pragma unroll
    for (int a = 0; a < 2; ++a)
#pragma unroll
        for (int b = 0; b < 2; ++b)
#pragma unroll
            for (int m = 0; m < 4; ++m)
#pragma unroll
                for (int n = 0; n < 2; ++n) acc[a][b][m][n] = (f32x4){0.f, 0.f, 0.f, 0.f};
    bf16x8 At[4][2], B0[2][2], B1[2][2];
    const char* cA = cur.a; const char* cB = cur.b;
    typename Epi::Pre pre = E.prefetch(cur, wr, fr);
#if PG8_SP2
    PG8_STAGE(PG8_SB(0, 0), cB, voffB); PG8_STAGE(PG8_SB(0, 1), cB + hstepB, voffB); PG8_STAGE(PG8_SA(0, 0), cA, voffA); PG8_STAGE(PG8_SA(0, 1), cA + hstepA, voffA);
    if (wr == 1) PG8_BAR;
    PG8_WAIT_V(2); PG8_BAR;
    PG8_STAGE(PG8_SB(1, 0), cB + kstep, voffB); PG8_STAGE(PG8_SA(1, 0), cA + kstep, voffA); PG8_STAGE(PG8_SB(1, 1), cB + hstepB + kstep, voffB);
    PG8_WAIT_V(6); PG8_BAR;
#else
    PG8_STAGE(PG8_SB(0, 0), cB, voffB); PG8_STAGE(PG8_SA(0, 0), cA, voffA); PG8_STAGE(PG8_SB(0, 1), cB + hstepB, voffB); PG8_STAGE(PG8_SA(0, 1), cA + hstepA, voffA);
    if (wr == 1) PG8_BAR;
    PG8_WAIT_V(4); PG8_BAR;
    PG8_STAGE(PG8_SB(1, 0), cB + kstep, voffB); PG8_STAGE(PG8_SA(1, 0), cA + kstep, voffA); PG8_STAGE(PG8_SB(1, 1), cB + hstepB + kstep, voffB);
    PG8_WAIT_V(6); PG8_BAR;
#endif
    for (;;) {
        const bool has_next = S.next(ui + 1, nxt);
        const char* nA = has_next ? nxt.a : cA; const char* nB = has_next ? nxt.b : cB;
        for (int t = 0; t < nt; t += 2) {
            const bool last = (t == nt - 2);
            const char* a1 = cA + (size_t)(t + 1) * kstep;
            const char* a2 = last ? nA : cA + (size_t)(t + 2) * kstep; const char* b2 = last ? nB : cB + (size_t)(t + 2) * kstep;
            const char* a3 = a2 + kstep; const char* b3 = b2 + kstep;
#if PG8_SP2
            PG8_LDB(B0, 0, 0); PG8_LDB(B1, 0, 1); PG8_SCHED; PG8_LDA(At, 0, 0); PG8_STAGE(PG8_SA(1, 1), a1 + hstepA, voffA);
            PG8_WAIT_V(8); PG8_WAIT_L(0); PG8_BAR; if (do0) { PG8_MMA(0, 0, At, B0); PG8_MMA(0, 1, At, B1); } PG8_BAR; PG8_SCHED;
            PG8_LDA(At, 0, 1); PG8_STAGE(PG8_SB(0, 0), b2, voffB); PG8_STAGE(PG8_SB(0, 1), b2 + hstepB, voffB); PG8_STAGE(PG8_SA(0, 0), a2, voffA);
            PG8_WAIT_V(8); PG8_WAIT_L(0); PG8_BAR; if (do1) { PG8_MMA(1, 0, At, B0); PG8_MMA(1, 1, At, B1); } PG8_BAR; PG8_SCHED;
            PG8_LDB(B0, 1, 0); PG8_LDB(B1, 1, 1); PG8_SCHED; PG8_LDA(At, 1, 0); PG8_STAGE(PG8_SA(0, 1), a2 + hstepA, voffA);
            PG8_WAIT_V(8); PG8_WAIT_L(0); PG8_BAR; if (do0) { PG8_MMA(0, 0, At, B0); PG8_MMA(0, 1, At, B1); } PG8_BAR; PG8_SCHED;
            PG8_LDA(At, 1, 1); PG8_STAGE(PG8_SB(1, 0), b3, voffB); PG8_STAGE(PG8_SB(1, 1), b3 + hstepB, voffB); PG8_STAGE(PG8_SA(1, 0), a3, voffA);
            PG8_WAIT_V(8); PG8_WAIT_L(0); PG8_BAR; if (do1) { PG8_MMA(1, 0, At, B0); PG8_MMA(1, 1, At, B1); } PG8_BAR; PG8_SCHED;
#else
            PG8_LDB(B0, 0, 0); PG8_SCHED; PG8_LDA(At, 0, 0); PG8_STAGE(PG8_SA(1, 1), a1 + hstepA, voffA);
            PG8_WAIT_L(8); PG8_BAR; PG8_WAIT_L(0); PG8_MMA(0, 0, At, B0); PG8_BAR; PG8_SCHED;
            PG8_LDB(B1, 0, 1); PG8_STAGE(PG8_SB(0, 0), b2, voffB);
            PG8_BAR; PG8_WAIT_L(0); PG8_MMA(0, 1, At, B1); PG8_BAR;
            PG8_LDA(At, 0, 1); PG8_STAGE(PG8_SA(0, 0), a2, voffA);
            PG8_BAR; PG8_WAIT_L(0); PG8_MMA(1, 0, At, B0); PG8_BAR; PG8_SCHED;
            PG8_STAGE(PG8_SB(0, 1), b2 + hstepB, voffB);
            PG8_WAIT_V(6); PG8_BAR; PG8_MMA(1, 1, At, B1); PG8_BAR;
            PG8_LDB(B0, 1, 0); PG8_SCHED; PG8_LDA(At, 1, 0); PG8_STAGE(PG8_SA(0, 1), a2 + hstepA, voffA);
            PG8_WAIT_L(8); PG8_BAR; PG8_WAIT_L(0); PG8_MMA(0, 0, At, B0); PG8_BAR; PG8_SCHED;
            PG8_LDB(B1, 1, 1); PG8_STAGE(PG8_SB(1, 0), b3, voffB);
            PG8_BAR; PG8_WAIT_L(0); PG8_MMA(0, 1, At, B1); PG8_BAR;
            PG8_LDA(At, 1, 1); PG8_STAGE(PG8_SA(1, 0), a3, voffA);
            PG8_BAR; PG8_WAIT_L(0); PG8_MMA(1, 0, At, B0); PG8_BAR; PG8_SCHED;
            PG8_STAGE(PG8_SB(1, 1), b3 + hstepB, voffB);
            PG8_WAIT_V(6); PG8_BAR; PG8_MMA(1, 1, At, B1); PG8_BAR;
#endif
        }
#if PG8_ALIGN
        if (wr == 0) PG8_BAR;
#endif
        E(acc, cur, wr, wc, fr, fq, pre);
        if (!has_next) break;
#pragma unroll
        for (int a = 0; a < 2; ++a)
#pragma unroll
            for (int b = 0; b < 2; ++b)
#pragma unroll
                for (int m = 0; m < 4; ++m)
#pragma unroll
                    for (int n = 0; n < 2; ++n) acc[a][b][m][n] = (f32x4){0.f, 0.f, 0.f, 0.f};
        cur = nxt; cA = nA; cB = nB; ++ui;
        pre = E.prefetch(cur, wr, fr);
#if PG8_ALIGN
        if (wr == 1) PG8_BAR;
#endif
    }
    PG8_WAIT_V(0);
#if !PG8_ALIGN
    if (wr == 0) PG8_BAR;
#endif
    PG8_BAR;
#undef PG8_SA
#undef PG8_SB
#undef PG8_STAGE
#undef PG8_LDA
#undef PG8_LDB
#undef PG8_MMA
#undef PG8_WAIT_V
#undef PG8_WAIT_L
#undef PG8_BAR
#undef PG8_SCHED
}
}

namespace attn {
using bf16 = __hip_bfloat16;
constexpr int HD = 128, NW = 8, QBLK = 32, KVBLK = 64;
constexpr float SCALE = 0.088388347648318440f;
constexpr float THR = 8.f;
constexpr int LDQ = QKVD, LDK = QKVD, LDO = D;
static_assert(SEQ / KVBLK == 64, "the attention ring schedule below is written for 64 key tiles");
constexpr size_t SHM_V = KVBLK * HD * 2, SHM_K = KVBLK * HD * 2, SHM_ATTN = 2 * SHM_V + 2 * SHM_K + NW * 64 * 4;
using bf16x8 = __attribute__((ext_vector_type(8))) short;
using s16x4  = __attribute__((ext_vector_type(4))) short;
using f32x16 = __attribute__((ext_vector_type(16))) float;
using u32x4  = __attribute__((ext_vector_type(4))) unsigned;
#define KSWZ(row, colB) ((row) * 256 + ((colB) ^ (((row) & 7) << 4)))
#define SBAR() __builtin_amdgcn_sched_barrier(0)
__device__ __forceinline__ int crow(int r, int hi) { return (r & 3) + 8 * (r >> 2) + 4 * hi; }
__device__ __forceinline__ unsigned cvtpk(float lo, float hi) { unsigned r; asm volatile("v_cvt_pk_bf16_f32 %0, %1, %2" : "=v"(r) : "v"(lo), "v"(hi)); return r; }
__device__ __forceinline__ bf16x8 ld8(const bf16* p) { return *reinterpret_cast<const bf16x8*>(p); }

__device__ __forceinline__ void partialSM(f32x16& p0, f32x16& p1, float mC) {
  constexpr float C = SCALE * 1.4426950408889634f;
  for (int r = 0; r < 16; ++r) p0[r] = fmaf(p0[r], C, mC); for (int r = 0; r < 16; ++r) p1[r] = fmaf(p1[r], C, mC);
  for (int r = 0; r < 16; ++r) p0[r] = __builtin_amdgcn_exp2f(p0[r]);
}
__device__ __forceinline__ void finishSM(f32x16& p0, f32x16& p1, float& l_reg, bf16x8& pa0, bf16x8& pa1, bf16x8& pa2, bf16x8& pa3) {
  for (int r = 0; r < 16; ++r) p1[r] = __builtin_amdgcn_exp2f(p1[r]);
  float ps = 0; for (int r = 0; r < 16; ++r) ps += p0[r]; for (int r = 0; r < 16; ++r) ps += p1[r];
  { auto rr = __builtin_amdgcn_permlane32_swap(__float_as_uint(ps), __float_as_uint(ps), false, false);
    ps = __uint_as_float(rr[0]) + __uint_as_float(rr[1]); }
  l_reg += ps;
#define PK4(P, BASE, OUT) do { unsigned a0 = cvtpk(P[BASE + 0], P[BASE + 1]), a1 = cvtpk(P[BASE + 2], P[BASE + 3]);   \
    unsigned b0 = cvtpk(P[BASE + 4], P[BASE + 5]), b1 = cvtpk(P[BASE + 6], P[BASE + 7]);                              \
    auto r0 = __builtin_amdgcn_permlane32_swap(a0, b0, false, false); auto r1 = __builtin_amdgcn_permlane32_swap(a1, b1, false, false); \
    u32x4 w = {r0[0], r1[0], r0[1], r1[1]}; OUT = *reinterpret_cast<bf16x8*>(&w); } while (0)
  PK4(p0, 0, pa0); PK4(p0, 8, pa1); PK4(p1, 0, pa2); PK4(p1, 8, pa3);
#undef PK4
}
__device__ __forceinline__ void qkt(f32x16& p0, f32x16& p1, const bf16* Ks, const bf16x8* qr, int r32, int hi) {
  p0 = f32x16{}; p1 = f32x16{};
  for (int d0 = 0; d0 < 8; ++d0) { int cb = (d0 * 16 + hi * 8) * 2;
    bf16x8 b0 = *reinterpret_cast<const bf16x8*>((const char*)Ks + KSWZ(r32, cb));
    bf16x8 b1 = *reinterpret_cast<const bf16x8*>((const char*)Ks + KSWZ(32 + r32, cb));
    p0 = __builtin_amdgcn_mfma_f32_32x32x16_bf16(b0, qr[d0], p0, 0, 0, 0);
    p1 = __builtin_amdgcn_mfma_f32_32x32x16_bf16(b1, qr[d0], p1, 0, 0, 0); }
}
__device__ __forceinline__ int v_st(int k, int c) { const int kk = (k & ~0xC) | ((k & 4) << 1) | ((k & 8) >> 1); return ((kk >> 3) * 4 + (c >> 5)) * 512 + ((kk & 7) * 32 + (c & 31)) * 2; }
__device__ __forceinline__ int v_rd_base(int lane) { return ((lane & 3) << 3) | (((lane >> 2) & 3) << 6) | (((lane >> 4) & 1) << 5) | (((lane >> 5) & 1) << 8); }
constexpr int v_rd_off(int d0, int ks, int half) { return d0 * 512 + ks * 4096 + half * 2048; }
template <int OFF> __device__ __forceinline__ s16x4 tr_read(int vb) {
  s16x4 r; asm volatile("ds_read_b64_tr_b16 %0, %1 offset:%2" : "=&v"(r) : "v"(vb), "i"(OFF) : "memory"); return r;
}
template <int D0> __device__ __forceinline__ void pv_one(f32x16& od, int vb, bf16x8 pa0, bf16x8 pa1, bf16x8 pa2, bf16x8 pa3) {
  const s16x4 l0 = tr_read<v_rd_off(D0, 0, 0)>(vb), h0 = tr_read<v_rd_off(D0, 0, 1)>(vb), l1 = tr_read<v_rd_off(D0, 1, 0)>(vb), h1 = tr_read<v_rd_off(D0, 1, 1)>(vb);
  const s16x4 l2 = tr_read<v_rd_off(D0, 2, 0)>(vb), h2 = tr_read<v_rd_off(D0, 2, 1)>(vb), l3 = tr_read<v_rd_off(D0, 3, 0)>(vb), h3 = tr_read<v_rd_off(D0, 3, 1)>(vb);
  asm volatile("s_waitcnt lgkmcnt(0)" ::: "memory"); SBAR();
#define PK(L, H) (bf16x8){L[0], L[1], L[2], L[3], H[0], H[1], H[2], H[3]}
  od = __builtin_amdgcn_mfma_f32_32x32x16_bf16(pa0, PK(l0, h0), od, 0, 0, 0);
  od = __builtin_amdgcn_mfma_f32_32x32x16_bf16(pa1, PK(l1, h1), od, 0, 0, 0);
  od = __builtin_amdgcn_mfma_f32_32x32x16_bf16(pa2, PK(l2, h2), od, 0, 0, 0);
  od = __builtin_amdgcn_mfma_f32_32x32x16_bf16(pa3, PK(l3, h3), od, 0, 0, 0);
#undef PK
}
__device__ __forceinline__ void pv_d0(f32x16* o, int vb, bf16x8 pa0, bf16x8 pa1, bf16x8 pa2, bf16x8 pa3) {
  s16x4 sl[6], sh[6]; const bf16x8 pav[4] = {pa0, pa1, pa2, pa3};
#define PVRD(i) do { sl[(i) % 6] = tr_read<v_rd_off((i) >> 2, (i) & 3, 0)>(vb); sh[(i) % 6] = tr_read<v_rd_off((i) >> 2, (i) & 3, 1)>(vb); } while (0)
#define PVMM(i, N) do { asm volatile("s_waitcnt lgkmcnt(" #N ")" ::: "memory"); SBAR(); \
    o[(i) >> 2] = __builtin_amdgcn_mfma_f32_32x32x16_bf16(pav[(i) & 3], (bf16x8){sl[(i) % 6][0], sl[(i) % 6][1], sl[(i) % 6][2], sl[(i) % 6][3], sh[(i) % 6][0], sh[(i) % 6][1], sh[(i) % 6][2], sh[(i) % 6][3]}, o[(i) >> 2], 0, 0, 0); SBAR(); } while (0)
  PVRD(0); PVRD(1); PVRD(2); PVRD(3); PVRD(4); PVRD(5);
  PVMM(0, 10); PVRD(6);
  PVMM(1, 10); PVRD(7);
  PVMM(2, 10); PVRD(8);
  PVMM(3, 10); PVRD(9);
  PVMM(4, 10); PVRD(10);
  PVMM(5, 10); PVRD(11);
  PVMM(6, 10); PVRD(12);
  PVMM(7, 10); PVRD(13);
  PVMM(8, 10); PVRD(14);
  PVMM(9, 10); PVRD(15);
  PVMM(10, 10);
  PVMM(11, 8);
  PVMM(12, 6);
  PVMM(13, 4);
  PVMM(14, 2);
  PVMM(15, 0);
#undef PVRD
#undef PVMM
}

__device__ __forceinline__ void attn_dense_body(const bf16* __restrict__ Qb, const bf16* __restrict__ Kh, const bf16* __restrict__ Vh,
                                                unsigned short* __restrict__ Ob, int seq, char* lds, const float* __restrict__ qg, int q0pos, float mC) {
  int tid = threadIdx.x; asm volatile("" : "+v"(tid));
  const int wid = tid >> 6, lane = tid & 63, r32 = lane & 31, hi = lane >> 5;
  bf16* K_lds = (bf16*)lds; bf16* V_lds = (bf16*)(lds + 3 * SHM_K);
  float* ws = (float*)(lds + 3 * SHM_V + 3 * SHM_K) + wid * 64; float* li_l = ws; float* al_l = ws + 32;
  float l_reg = 0; bf16x8 qr[8];
  const bf16* Qw = Qb + (long)(wid * QBLK + r32) * LDQ + hi * 8;
  {
    const float* qgl = qg; int hio = hi; asm volatile("" : "+s"(qgl), "+v"(hio));
#pragma unroll
    for (int d0 = 0; d0 < 8; ++d0) qr[d0] = ld8(Qw + d0 * 16);
    float ss = 0.f;
#pragma unroll
    for (int d0 = 0; d0 < 8; ++d0)
#pragma unroll
      for (int e = 0; e < 8; ++e) { const float v = __builtin_bit_cast(float, (unsigned)(unsigned short)qr[d0][e] << 16); ss += v * v; }
    { auto rr = __builtin_amdgcn_permlane32_swap(__float_as_uint(ss), __float_as_uint(ss), false, false); ss = __uint_as_float(rr[0]) + __uint_as_float(rr[1]); }
    const float rs = 1.0f / sqrtf(ss * (1.0f / 128.0f) + 1e-6f);
    const int spos = q0pos + wid * QBLK + r32;
#pragma unroll
    for (int ax = 0; ax < 2; ++ax) { const float pp = (float)(ax ? (spos & 63) : (spos >> 6));
#pragma unroll
      for (int dd = 0; dd < 2; ++dd) { const int d1 = ax * 4 + dd, d2 = d1 + 2; float o1[8], o2[8];
#pragma unroll
        for (int e = 0; e < 8; ++e) { const int j = dd * 16 + hio * 8 + e;
          const float rev = pp * (exp2f(-(float)j * 0.4152410118609203f) * 0.15915494309189535f);
          const float c = __builtin_amdgcn_cosf(rev), sn = __builtin_amdgcn_sinf(rev);
          const float x1 = __builtin_bit_cast(float, (unsigned)(unsigned short)qr[d1][e] << 16), x2 = __builtin_bit_cast(float, (unsigned)(unsigned short)qr[d2][e] << 16);
          const float y1 = x1 * rs * qgl[d1 * 16 + hio * 8 + e], y2 = x2 * rs * qgl[d2 * 16 + hio * 8 + e];
          o1[e] = y1 * c - y2 * sn; o2[e] = y2 * c + y1 * sn; }
        { u32x4 w = {cvtpk(o1[0], o1[1]), cvtpk(o1[2], o1[3]), cvtpk(o1[4], o1[5]), cvtpk(o1[6], o1[7])}; qr[d1] = *reinterpret_cast<bf16x8*>(&w); }
        { u32x4 w = {cvtpk(o2[0], o2[1]), cvtpk(o2[2], o2[3]), cvtpk(o2[4], o2[5]), cvtpk(o2[6], o2[7])}; qr[d2] = *reinterpret_cast<bf16x8*>(&w); } } }
  }
  f32x16 o[4] = {};
  const int sr = tid >> 4, sc = (tid & 15) * 8, vst0 = v_st(sr, sc), vst1 = v_st(32 + sr, sc);
  const int vb0 = (int)(uintptr_t)V_lds + v_rd_base(lane);
  struct { bf16x8 vs0, vs1, ks0, ks1; } sr_[2];
#define SLOAD(i, k0) do { sr_[i].vs0 = ld8(&Vh[(long)((k0) + sr) * LDK + sc]); sr_[i].vs1 = ld8(&Vh[(long)((k0) + 32 + sr) * LDK + sc]); \
    sr_[i].ks0 = ld8(&Kh[(long)((k0) + sr) * LDK + sc]); sr_[i].ks1 = ld8(&Kh[(long)((k0) + 32 + sr) * LDK + sc]); } while (0)
#define SWRITE(b, i) do { *(bf16x8*)((char*)V_lds + (b) * SHM_V + vst0) = sr_[i].vs0;          \
    *(bf16x8*)((char*)V_lds + (b) * SHM_V + vst1) = sr_[i].vs1; int kc = sc * 2;               \
    *(bf16x8*)((char*)K_lds + (b) * SHM_K + KSWZ(sr, kc)) = sr_[i].ks0;                       \
    *(bf16x8*)((char*)K_lds + (b) * SHM_K + KSWZ(32 + sr, kc)) = sr_[i].ks1; } while (0)
#define SWAIT() asm volatile("s_waitcnt vmcnt(4)" ::: "memory")
  f32x16 pA0, pA1, pB0, pB1; bf16x8 pa0, pa1, pa2, pa3; const int NT = seq / KVBLK;
  constexpr int SE = 0, SO = 1;
#define SWRITEO(off, i) do { *(bf16x8*)((char*)V_lds + (off) + vst0) = sr_[i].vs0; *(bf16x8*)((char*)V_lds + (off) + vst1) = sr_[i].vs1; const int kc_ = sc * 2; \
    *(bf16x8*)((char*)K_lds + (off) + KSWZ(sr, kc_)) = sr_[i].ks0; *(bf16x8*)((char*)K_lds + (off) + KSWZ(32 + sr, kc_)) = sr_[i].ks1; } while (0)
#define ASTEP(PX0, PX1, PY0, PY1, SC, SP, SN, T, HASNEXT) do {                                                                               \
    SBAR(); qkt(PX0, PX1, (bf16*)((char*)K_lds + (SC) * (int)SHM_K), qr, r32, hi);                                                          \
    finishSM(PY0, PY1, l_reg, pa0, pa1, pa2, pa3); SBAR();                                                                                  \
    if (HASNEXT) SLOAD(0, ((T) + 1) * KVBLK); SBAR();                                    \
    pv_d0(o, vb0 + (SP) * (int)SHM_V, pa0, pa1, pa2, pa3); partialSM(PX0, PX1, mC);                                                        \
    if (HASNEXT) { asm volatile("s_waitcnt vmcnt(0)" ::: "memory"); SWRITEO((SN) * (int)SHM_K, 0); __syncthreads(); } } while (0)
  SLOAD(0, 0); asm volatile("s_waitcnt vmcnt(0)" ::: "memory"); SWRITEO(0, 0);
  SLOAD(0, KVBLK);
  __syncthreads();
  qkt(pA0, pA1, K_lds, qr, r32, hi); partialSM(pA0, pA1, mC);
  asm volatile("s_waitcnt vmcnt(0)" ::: "memory"); SWRITEO((int)SHM_K, 0);
  __syncthreads();
  for (int j = 1; j + 8 < NT; j += 6) {
    ASTEP(pB0, pB1, pA0, pA1, 1, 0, 2, j,     1);
    ASTEP(pA0, pA1, pB0, pB1, 2, 1, 0, j + 1, 1);
    ASTEP(pB0, pB1, pA0, pA1, 0, 2, 1, j + 2, 1);
    ASTEP(pA0, pA1, pB0, pB1, 1, 0, 2, j + 3, 1);
    ASTEP(pB0, pB1, pA0, pA1, 2, 1, 0, j + 4, 1);
    ASTEP(pA0, pA1, pB0, pB1, 0, 2, 1, j + 5, 1);
  }
  ASTEP(pB0, pB1, pA0, pA1, 1, 0, 2, NT - 3, 1);
  ASTEP(pA0, pA1, pB0, pB1, 2, 1, 0, NT - 2, 1);
  ASTEP(pB0, pB1, pA0, pA1, 0, 2, 1, NT - 1, 0);
  finishSM(pB0, pB1, l_reg, pa0, pa1, pa2, pa3); SBAR();
  pv_d0(o, vb0, pa0, pa1, pa2, pa3);
#undef ASTEP
#undef SWRITEO
  if (hi == 0) li_l[r32] = l_reg; asm volatile("s_waitcnt lgkmcnt(0)" ::: "memory");
  float rli[16];
#pragma unroll
  for (int r = 0; r < 16; ++r) rli[r] = __builtin_amdgcn_rcpf(li_l[crow(r, hi)]);
  unsigned short* Ow = Ob + (long)(wid * QBLK) * LDO;
#pragma unroll
  for (int r = 0; r < 16; ++r) { int orow = crow(r, hi);
    for (int d0 = 0; d0 < 4; ++d0) Ow[(long)orow * LDO + d0 * 32 + r32] = (unsigned short)(cvtpk(o[d0][r] * rli[r], 0.f) & 0xffffu); }
  __syncthreads();
#undef SLOAD
#undef SWRITE
#undef SWAIT
}
}

#define LAS __attribute__((address_space(3)))
typedef unsigned short bf16_t;
typedef float f32x4 __attribute__((ext_vector_type(4)));
typedef unsigned v4u __attribute__((ext_vector_type(4)));
typedef unsigned v2u __attribute__((ext_vector_type(2)));
constexpr size_t MiB = 1u << 20;
constexpr size_t WS_WOUT = 1 * MiB, WS_WQKV = 3 * MiB, WS_WO = 6 * MiB, WS_WUP = 8 * MiB, WS_WDN = 24 * MiB, WS_WC = 40 * MiB, WS_FA = 40 * MiB + 65536, WS_FB = 41 * MiB, WS_SSQ = 42 * MiB  ;
constexpr size_t WS_R1 = 48 * MiB;
constexpr size_t WS_R2 = 240 * MiB;
constexpr size_t WS_YT = WS_R2 + 384 * MiB;
constexpr size_t WS_END = WS_R2 + 768 * MiB;
constexpr int LDS_BYTES = 131072 + 4096;
constexpr int N_PHASES = 14;

__device__ __forceinline__ unsigned f2bf(float f) { unsigned u = __builtin_bit_cast(unsigned, f); return (u + 0x7fffu + ((u >> 16) & 1u)) >> 16; }
__device__ __forceinline__ unsigned pk2(float lo, float hi) { return f2bf(lo) | (f2bf(hi) << 16); }
__device__ __forceinline__ float bf2f(unsigned short b) { return __builtin_bit_cast(float, (unsigned)b << 16); }
__device__ __forceinline__ float wave_sum(float v) {
#pragma unroll
    for (int o = 1; o < 64; o <<= 1) v += __shfl_xor(v, o);
    return v;
}
__device__ __forceinline__ void transpose_item(const float* W, int K, int N, bf16_t* WT, LAS float* scr, int item, int lane, const float* gain = nullptr) {
    const int nblk = N / 32, kb = item / nblk, nb = item % nblk, k0 = 64 * kb, n0 = 32 * nb;
#pragma unroll 8
    for (int i = 0; i < 32; ++i) { const int kk = 2 * i + (lane >> 5); const float gk = gain ? gain[k0 + kk] : 1.0f; scr[kk * 33 + (lane & 31)] = W[(size_t)(k0 + kk) * N + n0 + (lane & 31)] * gk; }
    asm volatile("s_waitcnt lgkmcnt(0)" ::: "memory");
    const int c = lane & 7;
#pragma unroll
    for (int j = 0; j < 4; ++j) { const int n = (lane >> 3) + 8 * j; const LAS float* s = scr + (8 * c) * 33 + n;
        v4u o; o.x = pk2(s[0 * 33], s[1 * 33]); o.y = pk2(s[2 * 33], s[3 * 33]); o.z = pk2(s[4 * 33], s[5 * 33]); o.w = pk2(s[6 * 33], s[7 * 33]);
        *(v4u*)(WT + (size_t)(n0 + n) * K + k0 + 8 * c) = o; }
    asm volatile("s_waitcnt lgkmcnt(0)" ::: "memory");
}
__device__ __forceinline__ void rms_rows_bf16(const float* x0, const float* x1, const float* g, bf16_t* out, int gw, int NGW, int ln) {
    f32x4 gv[4];
#pragma unroll
    for (int j = 0; j < 4; ++j) gv[j] = ((const f32x4*)g)[ln + 64 * j];
    for (int m = gw * 4; m < T; m += NGW * 4) {
        const float* xr = (m < T_PROMPT) ? x0 + (size_t)m * D : x1 + (size_t)(m - T_PROMPT) * D;
        f32x4 v[4][4];
#pragma unroll
        for (int r = 0; r < 4; ++r)
#pragma unroll
            for (int j = 0; j < 4; ++j) v[r][j] = ((const f32x4*)(xr + r * D))[ln + 64 * j];
#pragma unroll
        for (int r = 0; r < 4; ++r) { float s = 0.f;
#pragma unroll
            for (int j = 0; j < 4; ++j) s += (v[r][j].x * v[r][j].x + v[r][j].y * v[r][j].y) + (v[r][j].z * v[r][j].z + v[r][j].w * v[r][j].w);
            const float rs = 1.0f / sqrtf(wave_sum(s) * (1.0f / D) + EPS);
            v2u* o8 = (v2u*)(out + (size_t)(m + r) * D) + ln;
#pragma unroll
            for (int j = 0; j < 4; ++j) { const f32x4 y = v[r][j] * rs * gv[j]; v2u w; w.x = pk2(y.x, y.y); w.y = pk2(y.z, y.w); o8[64 * j] = w; } }
    }
}
__device__ __forceinline__ void rms_rows_final(const bf16_t* xs, const float* g, float* o, int gw, int NGW, int ln) {
    f32x4 gv[2][2];
#pragma unroll
    for (int j = 0; j < 2; ++j) { gv[j][0] = ((const f32x4*)g)[2 * ln + 128 * j]; gv[j][1] = ((const f32x4*)g)[2 * ln + 128 * j + 1]; }
    for (int m = gw * 4; m < T; m += NGW * 4) {
        v4u raw[4][2];
#pragma unroll
        for (int r = 0; r < 4; ++r)
#pragma unroll
            for (int j = 0; j < 2; ++j) raw[r][j] = ((const v4u*)(xs + (size_t)(m + r) * D))[ln + 64 * j];
#pragma unroll
        for (int r = 0; r < 4; ++r) { float x[2][8]; float sq = 0.f;
#pragma unroll
            for (int j = 0; j < 2; ++j)
#pragma unroll
                for (int e = 0; e < 4; ++e) { x[j][2 * e] = __builtin_bit_cast(float, raw[r][j][e] << 16); x[j][2 * e + 1] = __builtin_bit_cast(float, raw[r][j][e] & 0xffff0000u); sq += x[j][2 * e] * x[j][2 * e] + x[j][2 * e + 1] * x[j][2 * e + 1]; }
            const float rs = 1.0f / sqrtf(wave_sum(sq) * (1.0f / D) + EPS);
            f32x4* orow = (f32x4*)(o + (size_t)(m + r) * D);
#pragma unroll
            for (int j = 0; j < 2; ++j) { orow[2 * ln + 128 * j] = (f32x4){x[j][0], x[j][1], x[j][2], x[j][3]} * rs * gv[j][0]; orow[2 * ln + 128 * j + 1] = (f32x4){x[j][4], x[j][5], x[j][6], x[j][7]} * rs * gv[j][1]; } }
    }
}

#define XB_TMO      128
#define XB_XCNT(j)  (256  + 64 * (j))
#define XB_XSUB(j)  (1280 + 64 * (j))
#define XB_XGEN(j)  (2304 + 64 * (j))
#define XB_TOP      3328
#define XB_TOPGEN   3392
#define XCD_BAR_WORDS 3456
#define XB_SPIN_CAP (1u << 18)

__device__ __forceinline__ unsigned xb_ld(unsigned* p)              { return __hip_atomic_load(p, __ATOMIC_RELAXED, __HIP_MEMORY_SCOPE_AGENT); }
__device__ __forceinline__ unsigned xb_add(unsigned* p, unsigned v) { return __hip_atomic_fetch_add(p, v, __ATOMIC_RELAXED, __HIP_MEMORY_SCOPE_AGENT); }
__device__ __forceinline__ unsigned xb_xcc_id() { return (unsigned)__builtin_amdgcn_s_getreg((3 << 11) | 20) & 0xFu; }
#define XB_SPIN(cond, bar) do { unsigned _sp = 0; while (cond) { __builtin_amdgcn_s_sleep(1); \
    if ((++_sp & 255u) == 0u) { if (xb_ld(&(bar)[XB_TMO])) break; if (_sp > XB_SPIN_CAP) { atomicAdd(&(bar)[XB_TMO], 1u); break; } } } } while (0)

struct XcdBarrier {
    unsigned* bar; unsigned x;
    volatile LAS unsigned* st;
};

__device__ __forceinline__ XcdBarrier xcd_barrier_post(unsigned* bar, volatile LAS unsigned* st) {
    XcdBarrier b; b.bar = bar; b.x = xb_xcc_id(); b.st = st;
    if (threadIdx.x == 0) (void)xb_add(&bar[XB_XCNT(b.x)], 1u);
    return b;
}
__device__ __forceinline__ void xcd_barrier_complete(unsigned* bar, unsigned x, unsigned& nloc, unsigned& nx) {
    const unsigned G = gridDim.x * gridDim.y * gridDim.z;
    unsigned sum, cnt, mine, sp = 0u;
    for (;;) {
        sum = 0u; cnt = 0u; mine = 0u;
#pragma unroll
        for (unsigned j = 0; j < 16; ++j) { const unsigned c = xb_ld(&bar[XB_XCNT(j)]); sum += c; cnt += (c > 0u) ? 1u : 0u; mine = (j == x) ? c : mine; }
        if (sum == G) break;
        __builtin_amdgcn_s_sleep(1);
        if ((++sp & 255u) == 0u) { if (xb_ld(&bar[XB_TMO])) break; if (sp > XB_SPIN_CAP) { atomicAdd(&bar[XB_TMO], 1u); break; } }
    }
    nloc = mine > 0u ? mine : 1u; nx = cnt > 0u ? cnt : 1u;
}

__device__ __forceinline__ void xcd_barrier(const XcdBarrier& b) {
    asm volatile("s_waitcnt vmcnt(0)" ::: "memory");
    __syncthreads();
    if (threadIdx.x == 0) {
        unsigned* bar = b.bar;
        __builtin_amdgcn_s_waitcnt(0);
        unsigned nloc = b.st[0], nx = b.st[1];
        if (nloc == 0u) { xcd_barrier_complete(bar, b.x, nloc, nx); b.st[0] = nloc; b.st[1] = nx; }
        const unsigned old = xb_add(&bar[XB_XSUB(b.x)], 1u);
        const unsigned gen = old / nloc;
        if (old + 1u == (gen + 1u) * nloc) {
            __builtin_amdgcn_fence(__ATOMIC_RELEASE, "agent");
            asm volatile("s_waitcnt vmcnt(0)" ::: "memory");
            const unsigned og = xb_add(&bar[XB_TOP], 1u);
            const unsigned tg = og / nx;
            if (og + 1u == (tg + 1u) * nx) xb_add(&bar[XB_TOPGEN], 1u);
            else XB_SPIN(xb_ld(&bar[XB_TOPGEN]) == tg, bar);
            __builtin_amdgcn_fence(__ATOMIC_ACQUIRE, "agent");
            xb_add(&bar[XB_XGEN(b.x)], 1u);
            asm volatile("s_waitcnt vmcnt(0)" ::: "memory");
        } else {
            XB_SPIN(xb_ld(&bar[XB_XGEN(b.x)]) == gen, bar);
            __builtin_amdgcn_fence(__ATOMIC_ACQUIRE, "agent");
            asm volatile("s_waitcnt vmcnt(0)" ::: "memory");
        }
    }
    __syncthreads();
}

struct Args { const float* in[13]; float* out; unsigned char* ws; int ph_lo, ph_hi; };

__global__ void __launch_bounds__(512, 2) fwd_megakernel(Args args) {
    extern __shared__ __attribute__((aligned(16))) unsigned char lds[];
#define TIDX ({ int t_ = threadIdx.x; asm volatile("" : "+v"(t_)); t_; })
#define tid TIDX
#define lane (TIDX & 63)
    const int wave = __builtin_amdgcn_readfirstlane(TIDX >> 6);
    const int G = gridDim.x, cb = blockIdx.x;
    const int gw = cb * 8 + wave, NGW = G * 8;
    unsigned char* ws = args.ws;
    const float* x_prompt = args.in[0]; const float* x_sample = args.in[1];
    const float* fourier_norm = args.in[2]; const float* fourier_w_out = args.in[3];
    const float* attn_norm = args.in[4]; const float* attn_w_qkv = args.in[5]; const float* q_gain = args.in[6]; const float* k_gain = args.in[7];
    const float* attn_w_o = args.in[8]; const float* mlp_norm = args.in[9]; const float* mlp_w_up = args.in[10]; const float* mlp_w_down = args.in[11]; const float* final_norm = args.in[12];
    float* out = args.out;
    bf16_t* WoutT = (bf16_t*)(ws + WS_WOUT); bf16_t* WqkvT = (bf16_t*)(ws + WS_WQKV); bf16_t* WoT = (bf16_t*)(ws + WS_WO);
    bf16_t* WupT = (bf16_t*)(ws + WS_WUP); bf16_t* WdnT = (bf16_t*)(ws + WS_WDN); bf16_t* Wc = (bf16_t*)(ws + WS_WC);
    bf16_t* R1 = (bf16_t*)(ws + WS_R1); bf16_t* R2 = (bf16_t*)(ws + WS_R2); bf16_t* YT = (bf16_t*)(ws + WS_YT); bf16_t* FA = (bf16_t*)(ws + WS_FA); bf16_t* FB = (bf16_t*)(ws + WS_FB); float* SSQ = (float*)(ws + WS_SSQ); bf16_t* OB = YT;
    PG8_LAS unsigned char* glds = (PG8_LAS unsigned char*)lds;
    const int lo = args.ph_lo, hi = args.ph_hi;
    volatile LAS unsigned* MISC = (volatile LAS unsigned*)((LAS unsigned char*)lds + 131072);
    if (tid < 16) MISC[tid] = 0u;
    __syncthreads();
    if (hi > 1000) cg::this_grid().sync();
    XcdBarrier xbar = xcd_barrier_post((unsigned*)ws, MISC + 8);
    int ph = 0;
#define PH_ON (lo <= ph && ph < hi)
#define PH_NEXT do { if (lo <= ph && ph + 1 < hi) xcd_barrier(xbar); ++ph; } while (0)

    if (PH_ON) {
        const long gtid = (long)cb * 512 + tid, NTH = (long)G * 512;
        LAS float* scr = (LAS float*)((LAS unsigned char*)lds + wave * 16384);
        constexpr int I_SQ = (D / 64) * (D / 32), I_QKV = (D / 64) * (QKVD / 32), I_UP = (D / 64) * (FF / 32), I_DN = (FF / 64) * (D / 32);
        constexpr int NITEMS = 2 * I_SQ + I_QKV + 2 * I_UP + 2 * I_DN;
        for (int it = gw; it < NITEMS; it += NGW) {
            int r = it;
            if (r < I_SQ) { transpose_item(fourier_w_out, D, D, WoutT, scr, r, lane); continue; } r -= I_SQ;
            if (r < I_SQ) { transpose_item(attn_w_o, D, D, WoT, scr, r, lane); continue; } r -= I_SQ;
            if (r < I_QKV) { transpose_item(attn_w_qkv, D, QKVD, WqkvT, scr, r, lane, attn_norm); continue; } r -= I_QKV;
            if (r < I_UP) { transpose_item(mlp_w_up, D, FF, WupT, scr, r, lane, mlp_norm); continue; } r -= I_UP;
            if (r < I_UP) { transpose_item(mlp_w_up + (size_t)D * FF, D, FF, WupT + (size_t)D * FF, scr, r, lane, mlp_norm + D); continue; } r -= I_UP;
            if (r < I_DN) { transpose_item(mlp_w_down, FF, D, WdnT, scr, r, lane); continue; } r -= I_DN;
            transpose_item(mlp_w_down + (size_t)D * FF, FF, D, WdnT + (size_t)D * FF, scr, r, lane);
        }
        for (long it = gtid; it < 256 * 128 / 8; it += NTH) {
            const int row = (int)(it >> 4), c0 = (int)(it & 15) * 8, l = row >> 1, ri = row & 1; float v[8];
#pragma unroll
            for (int e = 0; e < 8; ++e) { const float ang = (float)((l * (c0 + e)) & 127) * (1.0f / 64.0f); v[e] = ri ? -sinpif(ang) : cospif(ang); }
            v4u o; o.x = pk2(v[0], v[1]); o.y = pk2(v[2], v[3]); o.z = pk2(v[4], v[5]); o.w = pk2(v[6], v[7]);
            *(v4u*)(Wc + (size_t)row * 128 + c0) = o;
        }
        for (long it = gtid; it < 128 * 128 / 8; it += NTH) {
            const int row = (int)(it >> 4), c0 = (int)(it & 15) * 8, k1 = row >> 1, ro = row & 1, ri = c0 >> 6; float v[8];
#pragma unroll
            for (int e = 0; e < 8; ++e) { const int s1 = (c0 + e) & 63; const float ang = (float)((k1 * s1) & 63) * (1.0f / 32.0f); const float cv = cospif(ang), sv = sinpif(ang);
                v[e] = (ro == ri) ? cv : (ro ? -sv : sv); }
            v4u o; o.x = pk2(v[0], v[1]); o.y = pk2(v[2], v[3]); o.z = pk2(v[4], v[5]); o.w = pk2(v[6], v[7]);
            *(v4u*)(FA + (size_t)row * 128 + c0) = o;
        }
        const float sc = 0.0013810679320049757f;
        for (long it = gtid; it < 64L * 64 * 128 / 8; it += NTH) {
            const int row = (int)(it >> 4), c0 = (int)(it & 15) * 8, k1 = row >> 6, k2 = row & 63, ro = c0 >> 6; float v[8];
#pragma unroll
            for (int e = 0; e < 8; ++e) { const int s2 = (c0 + e) & 63; const float ang = (float)(((k1 + 64 * k2) * s2) & 4095) * (1.0f / 2048.0f); v[e] = (ro ? sinpif(ang) : cospif(ang)) * sc; }
            v4u o; o.x = pk2(v[0], v[1]); o.y = pk2(v[2], v[3]); o.z = pk2(v[4], v[5]); o.w = pk2(v[6], v[7]);
            *(v4u*)(FB + (size_t)row * 128 + c0) = o;
        }
        for (long it = gtid; it < 4L * T / 4; it += NTH) ((f32x4*)SSQ)[it] = (f32x4){0.f, 0.f, 0.f, 0.f};
        rms_rows_bf16(x_prompt, x_sample, fourier_norm, R1, gw, NGW, lane);
    }
    PH_NEXT;
    if (PH_ON) {
        int kk = 128; asm volatile("" : "+s"(kk));
        pg8::Gemm g{kk, 128, D, 128 * 128 * 2, 2 * D * 2, 127, 1, 0}; pg8::SchedChan S{(const char*)Wc, (const char*)R1, G, cb};
        pg8::EpiChan E{R2};
        pg8::gemm_phase(glds, g, S, E);
    }
    PH_NEXT;
    if (PH_ON) {
        int kk = 128; asm volatile("" : "+s"(kk));
        pg8::Gemm g{kk, 128, 128, 0, 128 * 128 * 2, 127, 0, 1}; pg8::SchedLin S{(const char*)FA, (const char*)R2, G, cb, NBATCH * 8 * 128 * 64 / 256, 0, 0};
        pg8::EpiStageA E{YT};
        pg8::gemm_phase(glds, g, S, E);
    }
    PH_NEXT;
    if (PH_ON) {
        int kk = 128; asm volatile("" : "+s"(kk));
        pg8::Gemm g{kk, 128, 128, 0, 128 * 128 * 2, 63, 0, 2}; pg8::SchedLin S{(const char*)FB, (const char*)YT, G, cb, NBATCH * 64 * 8 * 128 / 256, 1, (size_t)64 * 128 * 2};
        pg8::EpiStageB E{R2};
        pg8::gemm_phase(glds, g, S, E);
    }
    PH_NEXT;
    if (PH_ON) {
        pg8::Gemm g = pg8::plain(D, D, D); pg8::SchedMN S{(const char*)R2, (const char*)WoutT, T / 256, D / 256, G, cb, (size_t)256 * D * 2, (size_t)256 * D * 2, D};
        pg8::EpiRes E{x_prompt, x_sample, T_PROMPT / 256, (size_t)T_PROMPT * D, R1, SSQ, D};
        pg8::gemm_phase(glds, g, S, E);
    }
    PH_NEXT;
    if (PH_ON) {
        pg8::Gemm g = pg8::plain(D, D, D); pg8::SchedMN S{(const char*)R1, (const char*)WupT, T / 256, FF / 256, G, cb, (size_t)256 * D * 2, (size_t)256 * D * 2, FF};
        pg8::EpiBf16<2> E{R2, FF, SSQ};
        pg8::gemm_phase(glds, g, S, E);
    }
    PH_NEXT;
    if (PH_ON) {
        pg8::Gemm g = pg8::plain(FF, FF, FF); pg8::SchedMN S{(const char*)R2, (const char*)WdnT, T / 256, D / 256, G, cb, (size_t)256 * FF * 2, (size_t)256 * FF * 2, D};
        pg8::EpiRes E{nullptr, nullptr, 0, 0, R1, SSQ + T, D};
        pg8::gemm_phase(glds, g, S, E);
    }
    PH_NEXT;
    if (PH_ON) {
        pg8::Gemm g = pg8::plain(D, D, D); pg8::SchedMN S{(const char*)R1, (const char*)WqkvT, T / 256, QKVD / 256, G, cb, (size_t)256 * D * 2, (size_t)256 * D * 2, QKVD};
        pg8::EpiBf16<0> E{R2, QKVD, SSQ + T};
        pg8::gemm_phase(glds, g, S, E);
    }
    PH_NEXT;
    if (PH_ON) {
        const int hs = lane >> 4, i16 = lane & 15, axis = i16 >> 3, x2half = (i16 >> 2) & 1, j0 = (i16 & 3) * 8;
        float inv[8], gk[8];
#pragma unroll
        for (int e = 0; e < 8; ++e) { inv[e] = exp2f(-(float)(2 * (j0 + e)) * (1.0f / 64.0f) * 13.287712379549449f) * 0.15915494309189535f;
            gk[e] = k_gain[i16 * 8 + e]; }
        for (int t0 = gw * 8; t0 < T; t0 += NGW * 8) {
            v4u raw[4];
#pragma unroll
            for (int u = 0; u < 4; ++u) raw[u] = *(const v4u*)(R2 + (size_t)(t0 + 2 * u + (hs >> 1)) * QKVD + 1024 + (hs & 1) * 128 + i16 * 8);
#pragma unroll
            for (int u = 0; u < 4; ++u) {
                const int t = t0 + 2 * u + (hs >> 1), sp = t & (SEQ - 1); const float p = (float)(axis ? (sp & 63) : (sp >> 6));
                float x[8];
#pragma unroll
                for (int e = 0; e < 4; ++e) { x[2 * e] = __builtin_bit_cast(float, raw[u][e] << 16); x[2 * e + 1] = __builtin_bit_cast(float, raw[u][e] & 0xffff0000u); }
                float ss = 0.f;
#pragma unroll
                for (int e = 0; e < 8; ++e) ss += x[e] * x[e];
                ss += __shfl_xor(ss, 1); ss += __shfl_xor(ss, 2); ss += __shfl_xor(ss, 4); ss += __shfl_xor(ss, 8);
                const float rs = 1.0f / sqrtf(ss * (1.0f / 128.0f) + EPS);
                float o[8];
#pragma unroll
                for (int e = 0; e < 8; ++e) { const float rev = p * inv[e]; const float cs = __builtin_amdgcn_cosf(rev); float sn = __builtin_amdgcn_sinf(rev); if (!x2half) sn = -sn;
                    const float y = x[e] * rs * gk[e]; const float pr = __shfl_xor(y, 4); o[e] = y * cs + pr * sn; }
                v4u w; w.x = pk2(o[0], o[1]); w.y = pk2(o[2], o[3]); w.z = pk2(o[4], o[5]); w.w = pk2(o[6], o[7]);
                *(v4u*)(R2 + (size_t)t * QKVD + 1024 + (hs & 1) * 128 + i16 * 8) = w;
            }
        }
    }
    PH_NEXT;
    if (PH_ON) {
        const int rounds = (NBATCH * 8 * 16 + G - 1) / G;
        float gqm = fmaxf(fabsf(q_gain[lane]), fabsf(q_gain[lane + 64])), gkm = fmaxf(fabsf(k_gain[lane]), fabsf(k_gain[lane + 64]));
#pragma unroll
        for (int o_ = 1; o_ < 64; o_ <<= 1) { gqm = fmaxf(gqm, __shfl_xor(gqm, o_)); gkm = fmaxf(gkm, __shfl_xor(gkm, o_)); }
        const float mC = -(128.0f * gqm * gkm * 1.02f) * (attn::SCALE * 1.4426950408889634f);
        for (int i = 0; i < rounds; ++i) {
            int b, h, qb;
            if (G == 256) { const int x = cb & 7, sl = cb >> 3; b = 2 * i + (x >> 2); const int kvh = (x >> 1) & 1; h = kvh * 4 + (x & 1) * 2 + (sl >> 4); qb = sl & 15; }
            else { const int u = i * G + cb; if (u >= NBATCH * 8 * 16) break; b = u >> 7; h = (u >> 4) & 7; qb = u & 15; }
            const int kvh = h >> 2;
            const attn::bf16* base = (const attn::bf16*)R2 + (size_t)b * SEQ * QKVD;
            attn::attn_dense_body(base + (size_t)qb * 256 * QKVD + h * 128, base + 1024 + kvh * 128, base + 1280 + kvh * 128,
                                  OB + ((size_t)b * SEQ + (size_t)qb * 256) * D + h * 128, SEQ, (char*)lds, q_gain, qb * 256, mC);
        }
    }
    PH_NEXT;
    if (PH_ON) {
        pg8::Gemm g = pg8::plain(D, D, D); pg8::SchedMN S{(const char*)OB, (const char*)WoT, T / 256, D / 256, G, cb, (size_t)256 * D * 2, (size_t)256 * D * 2, D};
        pg8::EpiRes E{nullptr, nullptr, 0, 0, R1, SSQ + 2 * T, D};
        pg8::gemm_phase(glds, g, S, E);
    }
    PH_NEXT;
    if (PH_ON) {
        pg8::Gemm g = pg8::plain(D, D, D); pg8::SchedMN S{(const char*)R1, (const char*)(WupT + (size_t)D * FF), T / 256, FF / 256, G, cb, (size_t)256 * D * 2, (size_t)256 * D * 2, FF};
        pg8::EpiBf16<2> E{R2, FF, SSQ + 2 * T};
        pg8::gemm_phase(glds, g, S, E);
    }
    PH_NEXT;
    if (PH_ON) {
        pg8::Gemm g = pg8::plain(FF, FF, FF); pg8::SchedMN S{(const char*)R2, (const char*)(WdnT + (size_t)D * FF), T / 256, D / 256, G, cb, (size_t)256 * FF * 2, (size_t)256 * FF * 2, D};
        pg8::EpiRes E{nullptr, nullptr, 0, 0, R1, SSQ + 3 * T, D};
        pg8::gemm_phase(glds, g, S, E);
    }
    PH_NEXT;
    if (PH_ON) rms_rows_final(R1, final_norm, out, gw, NGW, lane);
#undef PH_ON
#undef PH_NEXT
#undef tid
#undef lane
}

extern "C" void kernel_launch(void* const* d_in, const int* in_sizes, int n_in, void* d_out, int out_size, void* d_ws, size_t ws_size, hipStream_t stream) {
    static int grid = 0;
    if (grid == 0) {
        if (n_in != 13 || out_size != T * D || ws_size < WS_END) { fprintf(stderr, "kernel_launch: shape/workspace mismatch (n_in %d out %d ws %zu, need %zu)\n", n_in, out_size, ws_size, (size_t)WS_END); grid = -1; return; }
        int dev = 0, cus = 0, per_cu = 0;
        if (hipGetDevice(&dev) != hipSuccess || hipDeviceGetAttribute(&cus, hipDeviceAttributeMultiprocessorCount, dev) != hipSuccess) { grid = -1; return; }
        if (hipFuncSetAttribute((const void*)fwd_megakernel, hipFuncAttributeMaxDynamicSharedMemorySize, LDS_BYTES) != hipSuccess) { fprintf(stderr, "kernel_launch: hipFuncSetAttribute failed\n"); grid = -1; return; }
        if (hipOccupancyMaxActiveBlocksPerMultiprocessor(&per_cu, (const void*)fwd_megakernel, 512, LDS_BYTES) != hipSuccess || per_cu < 1) { fprintf(stderr, "kernel_launch: occupancy query says %d\n", per_cu); per_cu = 1; }
        (void)hipGetLastError();
        grid = cus;
    }
    if (grid < 0) return;
    (void)hipMemsetAsync(d_ws, 0, 16384, stream);
    Args a{};
    for (int i = 0; i < 13; ++i) a.in[i] = (const float*)d_in[i];
    a.out = (float*)d_out; a.ws = (unsigned char*)d_ws;
#if MK_PER_PHASE
    for (int p = 0; p < N_PHASES; ++p) { a.ph_lo = p; a.ph_hi = p + 1; hipLaunchKernelGGL(fwd_megakernel, dim3(grid), dim3(512), LDS_BYTES, stream, a); }
#else
    a.ph_lo = 0; a.ph_hi = N_PHASES;
    void* kargs[] = {&a};
    hipError_t e = hipLaunchCooperativeKernel((const void*)fwd_megakernel, dim3(grid), dim3(512), kargs, LDS_BYTES, stream);
    if (e != hipSuccess) fprintf(stderr, "kernel_launch: cooperative launch failed: %s (grid %d)\n", hipGetErrorString(e), grid);
#endif
}
```

```cpp
#include <hip/hip_runtime.h>
#include <hip/hip_bf16.h>
#include <hip/hip_cooperative_groups.h>
#include <cstdio>
#include <cstdint>
namespace cg = cooperative_groups;

#ifndef MK_PER_PHASE
#define MK_PER_PHASE 0
#endif

constexpr int D = 1024, SEQ = 4096, NBATCH = 24, T = NBATCH * SEQ;
constexpr int T_PROMPT = 8 * SEQ;
constexpr int FF = 4096, QKVD = 1536;
constexpr float EPS = 1e-6f;

#ifndef PG8_ALIGN
#define PG8_ALIGN 1
#endif
#ifndef PG8_SP2
#define PG8_SP2 1
#endif
namespace pg8 {
#define PG8_LAS __attribute__((address_space(3)))
typedef unsigned short bf16_t;
typedef short bf16x8 __attribute__((ext_vector_type(8)));
typedef float f32x4 __attribute__((ext_vector_type(4)));
typedef unsigned u32x4 __attribute__((ext_vector_type(4)));
constexpr int BM = 256, BK = 64, HALF = 128, HTB = HALF * BK * 2, STAGE_BYTES = 8 * HTB, NXCD = 8, WGM = 8;

__host__ __device__ __forceinline__ int lds_byte(int r, int c) { const int st = (r >> 4) * 2 + (c >> 5), rr = r & 15, cc = c & 31, ob = rr * 64 + cc * 2; return st * 1024 + (ob ^ (((ob >> 9) & 1) << 5)); }
__host__ __device__ __forceinline__ void stage_rc(int b, int& R, int& C) { const int st = b / 1024, sb = b % 1024, swz = sb ^ (((sb >> 9) & 1) << 5); R = (st >> 1) * 16 + swz / 64; C = (st & 1) * 32 + (swz % 64) / 2; }
__host__ __device__ __forceinline__ int perm32(int rho) { const int n = rho >> 4, i = rho & 15; return 8 * (i >> 2) + 4 * n + (i & 3); }

struct Unit { int pm, pn; const char* a; const char* b; size_t c; };
struct Gemm { int K, lda, ldb; unsigned hsA, hsB; int amask, bmode; int skip; };
__device__ __forceinline__ Gemm plain(int K, int lda, int ldb) { return Gemm{K, lda, ldb, (unsigned)(HALF * lda * 2), (unsigned)(HALF * ldb * 2), 127, 0, 0}; }

__device__ __forceinline__ bool tile_decode(int i, int G, int c, int nM, int nN, int& pm, int& pn) {
    const int nwg = nM * nN; const long L = (long)i * G + c; if (L >= nwg) return false;
    int wgid = (int)L; { const int q = nwg / NXCD, r = nwg % NXCD, xcd = wgid % NXCD, off = wgid / NXCD; wgid = (xcd < r ? xcd * (q + 1) : r * (q + 1) + (xcd - r) * q) + off; }
    const int nig = WGM * nN, gid = wgid / nig, fm = gid * WGM, gsz = (nM - fm) < WGM ? (nM - fm) : WGM;
    pm = fm + ((wgid % nig) % gsz); pn = (wgid % nig) / gsz; return true;
}
struct SchedMN {
    const char* A; const char* B; int nM, nN, G, c; size_t a_tile, b_tile; int ldc;
    __device__ __forceinline__ bool next(int i, Unit& u) const {
        if (!tile_decode(i, G, c, nM, nN, u.pm, u.pn)) return false;
        u.a = A + (size_t)u.pm * a_tile; u.b = B + (size_t)u.pn * b_tile; u.c = (size_t)u.pm * BM * ldc + (size_t)u.pn * BM; return true;
    }
};
struct SchedChan {
    const char* A; const char* B; int G, c;
    __device__ __forceinline__ bool next(int i, Unit& u) const {
        if (!tile_decode(i, G, c, NBATCH * 8, SEQ / BM, u.pm, u.pn)) return false;
        u.a = A; u.b = B + (((size_t)(u.pm >> 3) * SEQ + (size_t)u.pn * 4) * D + (size_t)(u.pm & 7) * 128) * 2; u.c = 0; return true;
    }
};
struct SchedLin {
    const char* A; const char* B; int G, c; int nN; int a_shift; size_t a_stride;
    __device__ __forceinline__ bool next(int i, Unit& u) const {
        if (!tile_decode(i, G, c, 1, nN, u.pm, u.pn)) return false;
        u.a = a_shift ? A + (size_t)((u.pn >> 2) & 63) * a_stride : A; u.b = B + (size_t)u.pn * BM * 128 * 2; u.c = 0; return true;
    }
};

__device__ __forceinline__ unsigned cvt_pk_bf16(float lo, float hi) { unsigned r; asm volatile("v_cvt_pk_bf16_f32 %0, %1, %2" : "=v"(r) : "v"(lo), "v"(hi)); return r; }

template <int ACT  > struct EpiBf16 {
    static constexpr bool PERM = true;
    bf16_t* O; int ldc; const float* ssq;
    struct Pre { float v[2][4]; };
    __device__ __forceinline__ Pre prefetch(const Unit& u, int wr, int fr) const {
        Pre p;
#pragma unroll
        for (int ai = 0; ai < 2; ++ai)
#pragma unroll
            for (int m = 0; m < 4; ++m) p.v[ai][m] = ssq ? ssq[u.pm * BM + wr * 64 + fr + ai * HALF + m * 16] : 0.f;
        return p;
    }
    __device__ __forceinline__ void operator()(const f32x4 (&acc)[2][2][4][2], const Unit& u, int wr, int wc, int fr, int fq, const Pre& pre) const {
        bf16_t* base = O + u.c + (size_t)(wr * 64 + fr) * ldc + wc * 32 + 8 * fq;
        float rs[2][4];
#pragma unroll
        for (int ai = 0; ai < 2; ++ai)
#pragma unroll
            for (int m = 0; m < 4; ++m) rs[ai][m] = ssq ? 1.0f / sqrtf(pre.v[ai][m] * (1.0f / 1024.0f) + 1e-6f) : 1.0f;
#pragma unroll
        for (int ai = 0; ai < 2; ++ai)
#pragma unroll
            for (int m = 0; m < 4; ++m) { bf16_t* rowp = base + (size_t)(ai * HALF + m * 16) * ldc;
#pragma unroll
                for (int bj = 0; bj < 2; ++bj) { f32x4 v0 = acc[ai][bj][m][0] * rs[ai][m], v1 = acc[ai][bj][m][1] * rs[ai][m];
                    if (ACT == 2) {
#pragma unroll
                        for (int e = 0; e < 4; ++e) { const float a0 = fmaxf(v0[e], 0.f), a1 = fmaxf(v1[e], 0.f); v0[e] = a0 * a0; v1[e] = a1 * a1; } }
                    u32x4 w; w.x = cvt_pk_bf16(v0[0], v0[1]); w.y = cvt_pk_bf16(v0[2], v0[3]); w.z = cvt_pk_bf16(v1[0], v1[1]); w.w = cvt_pk_bf16(v1[2], v1[3]);
                    *(u32x4*)(rowp + bj * HALF) = w; } }
    }
};
struct EpiRes {
    static constexpr bool PERM = true;
    struct Pre {}; __device__ __forceinline__ Pre prefetch(const Unit&, int, int) const { return Pre{}; }
    const float* res0; const float* res1; int split_pm; size_t split_off;
    bf16_t* xs; float* ssq; int ldc;
    __device__ __forceinline__ void operator()(const f32x4 (&acc)[2][2][4][2], const Unit& u, int wr, int wc, int fr, int fq, const Pre&) const {
        const float* rb = res0 ? ((u.pm < split_pm) ? res0 + u.c : res1 + (u.c - split_off)) : nullptr;
        bf16_t* xbt = xs + u.c; float* sqt = ssq + u.pm * BM;
        unsigned off0 = (unsigned)((wr * 64 + fr) * ldc + wc * 32 + 8 * fq), roff = (unsigned)(wr * 64 + fr);
        asm volatile("" : "+v"(off0), "+v"(roff));
#pragma unroll
        for (int am = 0; am < 4; ++am) { const int ai = am >> 1, mb = (am & 1) * 2;
            f32x4 rr[4][2][2];
#pragma unroll
            for (int m = mb; m < mb + 2; ++m)
#pragma unroll
                for (int bj = 0; bj < 2; ++bj) { const unsigned o = off0 + (unsigned)((ai * HALF + m * 16) * ldc) + bj * HALF;
                    if (res0) { rr[m][bj][0] = *(const f32x4*)(rb + o); rr[m][bj][1] = *(const f32x4*)(rb + o + 4); }
                    else { const u32x4 w = *(const u32x4*)(xbt + o);
                        rr[m][bj][0] = (f32x4){__builtin_bit_cast(float, w.x << 16), __builtin_bit_cast(float, w.x & 0xffff0000u), __builtin_bit_cast(float, w.y << 16), __builtin_bit_cast(float, w.y & 0xffff0000u)};
                        rr[m][bj][1] = (f32x4){__builtin_bit_cast(float, w.z << 16), __builtin_bit_cast(float, w.z & 0xffff0000u), __builtin_bit_cast(float, w.w << 16), __builtin_bit_cast(float, w.w & 0xffff0000u)}; } }
            asm volatile("" ::: "memory");
#pragma unroll
            for (int m = mb; m < mb + 2; ++m) { const unsigned off = off0 + (unsigned)((ai * HALF + m * 16) * ldc); float sq = 0.f;
#pragma unroll
                for (int bj = 0; bj < 2; ++bj) {
                    const f32x4 x0 = rr[m][bj][0] + acc[ai][bj][m][0], x1 = rr[m][bj][1] + acc[ai][bj][m][1];
                    sq += ((x0[0] * x0[0] + x0[1] * x0[1]) + (x0[2] * x0[2] + x0[3] * x0[3])) + ((x1[0] * x1[0] + x1[1] * x1[1]) + (x1[2] * x1[2] + x1[3] * x1[3]));
                    u32x4 w; w.x = cvt_pk_bf16(x0[0], x0[1]); w.y = cvt_pk_bf16(x0[2], x0[3]); w.z = cvt_pk_bf16(x1[0], x1[1]); w.w = cvt_pk_bf16(x1[2], x1[3]);
                    *(u32x4*)(xbt + off + bj * HALF) = w; }
                sq += __shfl_xor(sq, 16); sq += __shfl_xor(sq, 32); if (fq == 0) atomicAdd(sqt + roff + (unsigned)(ai * HALF + m * 16), sq); }
            asm volatile("" ::: "memory"); }
    }
};
__device__ __forceinline__ void store8(bf16_t* p, const f32x4& v0, const f32x4& v1) {
    u32x4 w; w.x = cvt_pk_bf16(v0[0], v0[1]); w.y = cvt_pk_bf16(v0[2], v0[3]); w.z = cvt_pk_bf16(v1[0], v1[1]); w.w = cvt_pk_bf16(v1[2], v1[3]); *(u32x4*)p = w;
}
struct EpiChan {
    static constexpr bool PERM = true;
    struct Pre {}; __device__ __forceinline__ Pre prefetch(const Unit&, int, int) const { return Pre{}; }
    bf16_t* O;
    __device__ __forceinline__ void operator()(const f32x4 (&acc)[2][2][4][2], const Unit& u, int wr, int wc, int fr, int fq, const Pre&) const {
#pragma unroll
        for (int ai = 0; ai < 2; ++ai)
#pragma unroll
            for (int m = 0; m < 4; ++m) { const int r = ai * HALF + wr * 64 + m * 16 + fr, l = r >> 1, ri = r & 1;
#pragma unroll
                for (int bj = 0; bj < 2; ++bj) { const int nl = bj * HALF + wc * 32 + 8 * fq, s2 = 4 * u.pn + (nl >> 6), s1 = nl & 63;
                    store8(O + ((((size_t)u.pm * 128 + l) * 64 + s2) * 2 + ri) * 64 + s1, acc[ai][bj][m][0], acc[ai][bj][m][1]); } }
    }
};
struct EpiStageA {
    static constexpr bool PERM = true;
    struct Pre {}; __device__ __forceinline__ Pre prefetch(const Unit&, int, int) const { return Pre{}; }
    bf16_t* O;
    __device__ __forceinline__ void operator()(const f32x4 (&acc)[2][2][4][2], const Unit& u, int wr, int wc, int fr, int fq, const Pre&) const {
        const int z = u.pn >> 5, l0 = (u.pn & 31) * 4, b = z >> 3, g = z & 7;
#pragma unroll
        for (int m = 0; m < 4; ++m) { const int r = wr * 64 + m * 16 + fr, k1 = r >> 1, ro = r & 1;
#pragma unroll
            for (int bj = 0; bj < 2; ++bj) { const int nl = bj * HALF + wc * 32 + 8 * fq, l = l0 + (nl >> 6), s2 = nl & 63;
                store8(O + ((((size_t)(b * 64 + k1) * 8 + g) * 128 + l) * 2 + ro) * 64 + s2, acc[0][bj][m][0], acc[0][bj][m][1]); } }
    }
};
struct EpiStageB {
    static constexpr bool PERM = true;
    struct Pre {}; __device__ __forceinline__ Pre prefetch(const Unit&, int, int) const { return Pre{}; }
    bf16_t* O;
    __device__ __forceinline__ void operator()(const f32x4 (&acc)[2][2][4][2], const Unit& u, int wr, int wc, int fr, int fq, const Pre&) const {
        if (wr != 0) return;
        const int bk = u.pn >> 2, b = bk >> 6, k1 = bk & 63, ch0 = (u.pn & 3) * 256;
#pragma unroll
        for (int m = 0; m < 4; ++m) { const int k2 = m * 16 + fr;
#pragma unroll
            for (int bj = 0; bj < 2; ++bj) { const int nl = bj * HALF + wc * 32 + 8 * fq;
                store8(O + ((size_t)b * SEQ + k1 + 64 * k2) * D + ch0 + nl, acc[0][bj][m][0], acc[0][bj][m][1]); } }
    }
};

template <class Epi, class Sched>
__device__ __forceinline__ void gemm_phase(PG8_LAS unsigned char* lds, const Gemm g, const Sched& S, const Epi& E) {
    const int tid = threadIdx.x, wid = __builtin_amdgcn_readfirstlane(tid >> 6), lane = tid & 63, wr = wid >> 2, wc = wid & 3, fr = lane & 15, fq = lane >> 4;
    const int K = g.K, nt = K / BK;
    const bool do1 = (g.skip == 0), do0 = (g.skip < 2) || (wr == 0);
    unsigned voffA[2], voffB[2];
#pragma unroll
    for (int i = 0; i < 2; ++i) { int R, C; stage_rc(tid * 16 + i * 8192, R, C); const int Rb = Epi::PERM ? ((R & ~31) + perm32(R & 31)) : R;
        const int Rbm = g.bmode ? ((Rb & 63) * 64 + (Rb >> 6)) : Rb;
        voffA[i] = (unsigned)((R & g.amask) * g.lda + C) * 2u; voffB[i] = (unsigned)(Rbm * g.ldb + C) * 2u; }
    const size_t kstep = (size_t)(BK * 2);
    const size_t hstepA = g.hsA, hstepB = g.hsB;
    const unsigned ldsw = (unsigned)wid * 1024u;
    const int aoff = lds_byte(wr * 64 + fr, fq * 8), boff = lds_byte(wc * 32 + fr, fq * 8);
#define PG8_SA(b, h) (((b) * 2 + (h)) * HTB)
#define PG8_SB(b, h) ((4 + (b) * 2 + (h)) * HTB)
#define PG8_STAGE(bufoff, gbase, voff) do { _Pragma("unroll") for (int _i = 0; _i < 2; ++_i) \
        __builtin_amdgcn_global_load_lds((const unsigned*)((const char*)(gbase) + (voff)[_i]), (PG8_LAS unsigned*)(lds + (bufoff) + ldsw + _i * 8192), 16, 0, 0); } while (0)
#define PG8_LDA(dst, b, h) do { _Pragma("unroll") for (int m = 0; m < 4; ++m) _Pragma("unroll") for (int k = 0; k < 2; ++k) dst[m][k] = *(const PG8_LAS bf16x8*)(lds + PG8_SA(b, h) + aoff + m * 2048 + k * 1024); } while (0)
#define PG8_LDB(dst, b, h) do { _Pragma("unroll") for (int n = 0; n < 2; ++n) _Pragma("unroll") for (int k = 0; k < 2; ++k) dst[n][k] = *(const PG8_LAS bf16x8*)(lds + PG8_SB(b, h) + boff + n * 2048 + k * 1024); } while (0)
#define PG8_MMA(ai, bj, At, Bt) do { __builtin_amdgcn_s_setprio(1); _Pragma("unroll") for (int m = 0; m < 4; ++m) _Pragma("unroll") for (int n = 0; n < 2; ++n) _Pragma("unroll") for (int k = 0; k < 2; ++k) \
        acc[ai][bj][m][n] = __builtin_amdgcn_mfma_f32_16x16x32_bf16(Bt[n][k], At[m][k], acc[ai][bj][m][n], 0, 0, 0); __builtin_amdgcn_s_setprio(0); } while (0)
#define PG8_WAIT_V(n) asm volatile("s_waitcnt vmcnt(" #n ")" ::: "memory")
#define PG8_WAIT_L(n) asm volatile("s_waitcnt lgkmcnt(" #n ")" ::: "memory")
#define PG8_BAR __builtin_amdgcn_s_barrier()
#define PG8_SCHED __builtin_amdgcn_sched_barrier(0)
    Unit cur, nxt; int ui = 0;
    if (!S.next(0, cur)) return;
    f32x4 acc[2][2][4][2];
#pragma unroll
    for (int a = 0; a < 2; ++a)
#pragma unroll
        for (int b = 0; b < 2; ++b)
#pragma unroll
            for (int m = 0; m < 4; ++m)
#pragma unroll
                for (int n = 0; n < 2; ++n) acc[a][b][m][n] = (f32x4){0.f, 0.f, 0.f, 0.f};
    bf16x8 At[4][2], B0[2][2], B1[2][2];
    const char* cA = cur.a; const char* cB = cur.b;
    typename Epi::Pre pre = E.prefetch(cur, wr, fr);
#if PG8_SP2
    PG8_STAGE(PG8_SB(0, 0), cB, voffB); PG8_STAGE(PG8_SB(0, 1), cB + hstepB, voffB); PG8_STAGE(PG8_SA(0, 0), cA, voffA); PG8_STAGE(PG8_SA(0, 1), cA + hstepA, voffA);
    if (wr == 1) PG8_BAR;
    PG8_WAIT_V(2); PG8_BAR;
    PG8_STAGE(PG8_SB(1, 0), cB + kstep, voffB); PG8_STAGE(PG8_SA(1, 0), cA + kstep, voffA); PG8_STAGE(PG8_SB(1, 1), cB + hstepB + kstep, voffB);
    PG8_WAIT_V(6); PG8_BAR;
#else
    PG8_STAGE(PG8_SB(0, 0), cB, voffB); PG8_STAGE(PG8_SA(0, 0), cA, voffA); PG8_STAGE(PG8_SB(0, 1), cB + hstepB, voffB); PG8_STAGE(PG8_SA(0, 1), cA + hstepA, voffA);
    if (wr == 1) PG8_BAR;
    PG8_WAIT_V(4); PG8_BAR;
    PG8_STAGE(PG8_SB(1, 0), cB + kstep, voffB); PG8_STAGE(PG8_SA(1, 0), cA + kstep, voffA); PG8_STAGE(PG8_SB(1, 1), cB + hstepB + kstep, voffB);
    PG8_WAIT_V(6); PG8_BAR;
#endif
    for (;;) {
        const bool has_next = S.next(ui + 1, nxt);
        const char* nA = has_next ? nxt.a : cA; const char* nB = has_next ? nxt.b : cB;
        for (int t = 0; t < nt; t += 2) {
            const bool last = (t == nt - 2);
            const char* a1 = cA + (size_t)(t + 1) * kstep;
            const char* a2 = last ? nA : cA + (size_t)(t + 2) * kstep; const char* b2 = last ? nB : cB + (size_t)(t + 2) * kstep;
            const char* a3 = a2 + kstep; const char* b3 = b2 + kstep;
#if PG8_SP2
            PG8_LDB(B0, 0, 0); PG8_LDB(B1, 0, 1); PG8_SCHED; PG8_LDA(At, 0, 0); PG8_STAGE(PG8_SA(1, 1), a1 + hstepA, voffA);
            PG8_WAIT_V(8); PG8_WAIT_L(0); PG8_BAR; if (do0) { PG8_MMA(0, 0, At, B0); PG8_MMA(0, 1, At, B1); } PG8_BAR; PG8_SCHED;
            PG8_LDA(At, 0, 1); PG8_STAGE(PG8_SB(0, 0), b2, voffB); PG8_STAGE(PG8_SB(0, 1), b2 + hstepB, voffB); PG8_STAGE(PG8_SA(0, 0), a2, voffA);
            PG8_WAIT_V(8); PG8_WAIT_L(0); PG8_BAR; if (do1) { PG8_MMA(1, 0, At, B0); PG8_MMA(1, 1, At, B1); } PG8_BAR; PG8_SCHED;
            PG8_LDB(B0, 1, 0); PG8_LDB(B1, 1, 1); PG8_SCHED; PG8_LDA(At, 1, 0); PG8_STAGE(PG8_SA(0, 1), a2 + hstepA, voffA);
            PG8_WAIT_V(8); PG8_WAIT_L(0); PG8_BAR; if (do0) { PG8_MMA(0, 0, At, B0); PG8_MMA(0, 1, At, B1); } PG8_BAR; PG8_SCHED;
            PG8_LDA(At, 1, 1); PG8_STAGE(PG8_SB(1, 0), b3, voffB); PG8_STAGE(PG8_SB(1, 1), b3 + hstepB, voffB); PG8_STAGE(PG8_SA(1, 0), a3, voffA);
            PG8_WAIT_V(8); PG8_WAIT_L(0); PG8_BAR; if (do1) { PG8_MMA(1, 0, At, B0); PG8_MMA(1, 1, At, B1); } PG8_BAR; PG8_SCHED;
#else
            PG8_LDB(B0, 0, 0); PG8_SCHED; PG8_LDA(At, 0, 0); PG8_STAGE(PG8_SA(1, 1), a1 + hstepA, voffA);
            PG8_WAIT_L(8); PG8_BAR; PG8_WAIT_L(0); PG8_MMA(0, 0, At, B0); PG8_BAR; PG8_SCHED;
            PG8_LDB(B1, 0, 1); PG8_STAGE(PG8_SB(0, 0), b2, voffB);
            PG8_BAR; PG8_WAIT_L(0); PG8_MMA(0, 1, At, B1); PG8_BAR;
            PG8_LDA(At, 0, 1); PG8_STAGE(PG8_SA(0, 0), a2, voffA);
            PG8_BAR; PG8_WAIT_L(0); PG8_MMA(1, 0, At, B0); PG8_BAR; PG8_SCHED;
            PG8_STAGE(PG8_SB(0, 1), b2 + hstepB, voffB);
            PG8_WAIT_V(6); PG8_BAR; PG8_MMA(1, 1, At, B1); PG8_BAR;
            PG8_LDB(B0, 1, 0); PG8_SCHED; PG8_LDA(At, 1, 0); PG8_STAGE(PG8_SA(0, 1), a2 + hstepA, voffA);
            PG8_WAIT_L(8); PG8_BAR; PG8_WAIT_L(0); PG8_MMA(0, 0, At, B0); PG8_BAR; PG8_SCHED;
            PG8_LDB(B1, 1, 1); PG8_STAGE(PG8_SB(1, 0), b3, voffB);
            PG8_BAR; PG8_WAIT_L(0); PG8_MMA(0, 1, At, B1); PG8_BAR;
            PG8_LDA(At, 1, 1); PG8_STAGE(PG8_SA(1, 0), a3, voffA);
            PG8_BAR; PG8_WAIT_L(0); PG8_MMA(1, 0, At, B0); PG8_BAR; PG8_SCHED;
            PG8_STAGE(PG8_SB(1, 1), b3 + hstepB, voffB);
            PG8_WAIT_V(6); PG8_BAR; PG8_MMA(1, 1, At, B1); PG8_BAR;
#endif
        }
#if PG8_ALIGN
        if (wr == 0) PG8_BAR;
#endif
        E(acc, cur, wr, wc, fr, fq, pre);
        if (!has_next) break;
#pragma unroll
        for (int a = 0; a < 2; ++a)
#pragma unroll
            for (int b = 0; b < 2; ++b)
#pragma unroll
                for (int m = 0; m < 4; ++m)
#pragma unroll
                    for (int n = 0; n < 2; ++n) acc[a][b][m][n] = (f32x4){0.f, 0.f, 0.f, 0.f};
        cur = nxt; cA = nA; cB = nB; ++ui;
        pre = E.prefetch(cur, wr, fr);
#if PG8_ALIGN
        if (wr == 1) PG8_BAR;
#endif
    }
    PG8_WAIT_V(0);
#if !PG8_ALIGN
    if (wr == 0) PG8_BAR;
#endif
    PG8_BAR;
#undef PG8_SA
#undef PG8_SB
#undef PG8_STAGE
#undef PG8_LDA
#undef PG8_LDB
#undef PG8_MMA
#undef PG8_WAIT_V
#undef PG8_WAIT_L
#undef PG8_BAR
#undef PG8_SCHED
}
}

namespace attn {
using bf16 = __hip_bfloat16;
constexpr int HD = 128, NW = 8, QBLK = 32, KVBLK = 64;
constexpr float SCALE = 0.088388347648318440f;
constexpr float THR = 8.f;
constexpr int LDQ = QKVD, LDK = QKVD, LDO = D;
constexpr size_t SHM_V = KVBLK * HD * 2, SHM_K = KVBLK * HD * 2, SHM_ATTN = 2 * SHM_V + 2 * SHM_K + NW * 64 * 4;
using bf16x8 = __attribute__((ext_vector_type(8))) short;
using s16x4  = __attribute__((ext_vector_type(4))) short;
using f32x16 = __attribute__((ext_vector_type(16))) float;
using u32x4  = __attribute__((ext_vector_type(4))) unsigned;
#define KSWZ(row, colB) ((row) * 256 + ((colB) ^ (((row) & 7) << 4)))
#define SBAR() __builtin_amdgcn_sched_barrier(0)
__device__ __forceinline__ int crow(int r, int hi) { return (r & 3) + 8 * (r >> 2) + 4 * hi; }
__device__ __forceinline__ unsigned cvtpk(float lo, float hi) { unsigned r; asm volatile("v_cvt_pk_bf16_f32 %0, %1, %2" : "=v"(r) : "v"(lo), "v"(hi)); return r; }
__device__ __forceinline__ bf16x8 ld8(const bf16* p) { return *reinterpret_cast<const bf16x8*>(p); }

__device__ __forceinline__ void partialSM(f32x16& p0, f32x16& p1, float mC) {
  constexpr float C = SCALE * 1.4426950408889634f;
  for (int r = 0; r < 16; ++r) p0[r] = fmaf(p0[r], C, mC); for (int r = 0; r < 16; ++r) p1[r] = fmaf(p1[r], C, mC);
  for (int r = 0; r < 16; ++r) p0[r] = __builtin_amdgcn_exp2f(p0[r]);
}
__device__ __forceinline__ void finishSM(f32x16& p0, f32x16& p1, float& l_reg, bf16x8& pa0, bf16x8& pa1, bf16x8& pa2, bf16x8& pa3) {
  for (int r = 0; r < 16; ++r) p1[r] = __builtin_amdgcn_exp2f(p1[r]);
  float ps = 0; for (int r = 0; r < 16; ++r) ps += p0[r]; for (int r = 0; r < 16; ++r) ps += p1[r];
  { auto rr = __builtin_amdgcn_permlane32_swap(__float_as_uint(ps), __float_as_uint(ps), false, false);
    ps = __uint_as_float(rr[0]) + __uint_as_float(rr[1]); }
  l_reg += ps;
#define PK4(P, BASE, OUT) do { unsigned a0 = cvtpk(P[BASE + 0], P[BASE + 1]), a1 = cvtpk(P[BASE + 2], P[BASE + 3]);   \
    unsigned b0 = cvtpk(P[BASE + 4], P[BASE + 5]), b1 = cvtpk(P[BASE + 6], P[BASE + 7]);                              \
    auto r0 = __builtin_amdgcn_permlane32_swap(a0, b0, false, false); auto r1 = __builtin_amdgcn_permlane32_swap(a1, b1, false, false); \
    u32x4 w = {r0[0], r1[0], r0[1], r1[1]}; OUT = *reinterpret_cast<bf16x8*>(&w); } while (0)
  PK4(p0, 0, pa0); PK4(p0, 8, pa1); PK4(p1, 0, pa2); PK4(p1, 8, pa3);
#undef PK4
}
__device__ __forceinline__ void qkt(f32x16& p0, f32x16& p1, const bf16* Ks, const bf16x8* qr, int r32, int hi) {
  p0 = f32x16{}; p1 = f32x16{};
  for (int d0 = 0; d0 < 8; ++d0) { int cb = (d0 * 16 + hi * 8) * 2;
    bf16x8 b0 = *reinterpret_cast<const bf16x8*>((const char*)Ks + KSWZ(r32, cb));
    bf16x8 b1 = *reinterpret_cast<const bf16x8*>((const char*)Ks + KSWZ(32 + r32, cb));
    p0 = __builtin_amdgcn_mfma_f32_32x32x16_bf16(b0, qr[d0], p0, 0, 0, 0);
    p1 = __builtin_amdgcn_mfma_f32_32x32x16_bf16(b1, qr[d0], p1, 0, 0, 0); }
}
__device__ __forceinline__ int v_st(int k, int c) { const int kk = (k & ~0xC) | ((k & 4) << 1) | ((k & 8) >> 1); return ((kk >> 3) * 4 + (c >> 5)) * 512 + ((kk & 7) * 32 + (c & 31)) * 2; }
__device__ __forceinline__ int v_rd_base(int lane) { return ((lane & 3) << 3) | (((lane >> 2) & 3) << 6) | (((lane >> 4) & 1) << 5) | (((lane >> 5) & 1) << 8); }
constexpr int v_rd_off(int d0, int ks, int half) { return d0 * 512 + ks * 4096 + half * 2048; }
template <int OFF> __device__ __forceinline__ s16x4 tr_read(int vb) {
  s16x4 r; asm volatile("ds_read_b64_tr_b16 %0, %1 offset:%2" : "=&v"(r) : "v"(vb), "i"(OFF) : "memory"); return r;
}
template <int D0> __device__ __forceinline__ void pv_one(f32x16& od, int vb, bf16x8 pa0, bf16x8 pa1, bf16x8 pa2, bf16x8 pa3) {
  const s16x4 l0 = tr_read<v_rd_off(D0, 0, 0)>(vb), h0 = tr_read<v_rd_off(D0, 0, 1)>(vb), l1 = tr_read<v_rd_off(D0, 1, 0)>(vb), h1 = tr_read<v_rd_off(D0, 1, 1)>(vb);
  const s16x4 l2 = tr_read<v_rd_off(D0, 2, 0)>(vb), h2 = tr_read<v_rd_off(D0, 2, 1)>(vb), l3 = tr_read<v_rd_off(D0, 3, 0)>(vb), h3 = tr_read<v_rd_off(D0, 3, 1)>(vb);
  asm volatile("s_waitcnt lgkmcnt(0)" ::: "memory"); SBAR();
#define PK(L, H) (bf16x8){L[0], L[1], L[2], L[3], H[0], H[1], H[2], H[3]}
  od = __builtin_amdgcn_mfma_f32_32x32x16_bf16(pa0, PK(l0, h0), od, 0, 0, 0);
  od = __builtin_amdgcn_mfma_f32_32x32x16_bf16(pa1, PK(l1, h1), od, 0, 0, 0);
  od = __builtin_amdgcn_mfma_f32_32x32x16_bf16(pa2, PK(l2, h2), od, 0, 0, 0);
  od = __builtin_amdgcn_mfma_f32_32x32x16_bf16(pa3, PK(l3, h3), od, 0, 0, 0);
#undef PK
}
__device__ __forceinline__ void pv_d0(f32x16* o, int vb, bf16x8 pa0, bf16x8 pa1, bf16x8 pa2, bf16x8 pa3) {
  pv_one<0>(o[0], vb, pa0, pa1, pa2, pa3); pv_one<1>(o[1], vb, pa0, pa1, pa2, pa3); pv_one<2>(o[2], vb, pa0, pa1, pa2, pa3); pv_one<3>(o[3], vb, pa0, pa1, pa2, pa3);
}

__device__ __forceinline__ void attn_dense_body(const bf16* __restrict__ Qb, const bf16* __restrict__ Kh, const bf16* __restrict__ Vh,
                                                unsigned short* __restrict__ Ob, int seq, char* lds, const float* __restrict__ qg, int q0pos, float mC) {
  int tid = threadIdx.x; asm volatile("" : "+v"(tid));
  const int wid = tid >> 6, lane = tid & 63, r32 = lane & 31, hi = lane >> 5;
  bf16* V_lds = (bf16*)lds; bf16* K_lds = (bf16*)(lds + 2 * SHM_V);
  float* ws = (float*)(lds + 2 * SHM_V + 2 * SHM_K) + wid * 64; float* li_l = ws; float* al_l = ws + 32;
  float l_reg = 0; bf16x8 qr[8];
  const bf16* Qw = Qb + (long)(wid * QBLK + r32) * LDQ + hi * 8;
  {
    const float* qgl = qg; int hio = hi; asm volatile("" : "+s"(qgl), "+v"(hio));
#pragma unroll
    for (int d0 = 0; d0 < 8; ++d0) qr[d0] = ld8(Qw + d0 * 16);
    float ss = 0.f;
#pragma unroll
    for (int d0 = 0; d0 < 8; ++d0)
#pragma unroll
      for (int e = 0; e < 8; ++e) { const float v = __builtin_bit_cast(float, (unsigned)(unsigned short)qr[d0][e] << 16); ss += v * v; }
    { auto rr = __builtin_amdgcn_permlane32_swap(__float_as_uint(ss), __float_as_uint(ss), false, false); ss = __uint_as_float(rr[0]) + __uint_as_float(rr[1]); }
    const float rs = 1.0f / sqrtf(ss * (1.0f / 128.0f) + 1e-6f);
    const int spos = q0pos + wid * QBLK + r32;
#pragma unroll
    for (int ax = 0; ax < 2; ++ax) { const float pp = (float)(ax ? (spos & 63) : (spos >> 6));
#pragma unroll
      for (int dd = 0; dd < 2; ++dd) { const int d1 = ax * 4 + dd, d2 = d1 + 2; float o1[8], o2[8];
#pragma unroll
        for (int e = 0; e < 8; ++e) { const int j = dd * 16 + hio * 8 + e;
          const float rev = pp * (exp2f(-(float)j * 0.4152410118609203f) * 0.15915494309189535f);
          const float c = __builtin_amdgcn_cosf(rev), sn = __builtin_amdgcn_sinf(rev);
          const float x1 = __builtin_bit_cast(float, (unsigned)(unsigned short)qr[d1][e] << 16), x2 = __builtin_bit_cast(float, (unsigned)(unsigned short)qr[d2][e] << 16);
          const float y1 = x1 * rs * qgl[d1 * 16 + hio * 8 + e], y2 = x2 * rs * qgl[d2 * 16 + hio * 8 + e];
          o1[e] = y1 * c - y2 * sn; o2[e] = y2 * c + y1 * sn; }
        { u32x4 w = {cvtpk(o1[0], o1[1]), cvtpk(o1[2], o1[3]), cvtpk(o1[4], o1[5]), cvtpk(o1[6], o1[7])}; qr[d1] = *reinterpret_cast<bf16x8*>(&w); }
        { u32x4 w = {cvtpk(o2[0], o2[1]), cvtpk(o2[2], o2[3]), cvtpk(o2[4], o2[5]), cvtpk(o2[6], o2[7])}; qr[d2] = *reinterpret_cast<bf16x8*>(&w); } } }
  }
  f32x16 o[4] = {};
  const int sr = tid >> 4, sc = (tid & 15) * 8, vst0 = v_st(sr, sc), vst1 = v_st(32 + sr, sc);
  const int vb0 = (int)(uintptr_t)V_lds + v_rd_base(lane);
  struct { bf16x8 vs0, vs1, ks0, ks1; } sr_[2];
#define SLOAD(i, k0) do { sr_[i].vs0 = ld8(&Vh[(long)((k0) + sr) * LDK + sc]); sr_[i].vs1 = ld8(&Vh[(long)((k0) + 32 + sr) * LDK + sc]); \
    sr_[i].ks0 = ld8(&Kh[(long)((k0) + sr) * LDK + sc]); sr_[i].ks1 = ld8(&Kh[(long)((k0) + 32 + sr) * LDK + sc]); } while (0)
#define SWRITE(b, i) do { *(bf16x8*)((char*)V_lds + (b) * SHM_V + vst0) = sr_[i].vs0;          \
    *(bf16x8*)((char*)V_lds + (b) * SHM_V + vst1) = sr_[i].vs1; int kc = sc * 2;               \
    *(bf16x8*)((char*)K_lds + (b) * SHM_K + KSWZ(sr, kc)) = sr_[i].ks0;                       \
    *(bf16x8*)((char*)K_lds + (b) * SHM_K + KSWZ(32 + sr, kc)) = sr_[i].ks1; } while (0)
#define SWAIT() asm volatile("s_waitcnt vmcnt(4)" ::: "memory")
  f32x16 pA0, pA1, pB0, pB1; bf16x8 pa0, pa1, pa2, pa3; const int NT = seq / KVBLK;
  constexpr int SE = 0, SO = 1;
  SLOAD(SE, 0); asm volatile("s_waitcnt vmcnt(0)" ::: "memory"); SWRITE(0, SE); __syncthreads();
  qkt(pA0, pA1, K_lds, qr, r32, hi); partialSM(pA0, pA1, mC);
  SLOAD(SO, KVBLK); if (2 < NT) SLOAD(SE, 2 * KVBLK);
  SWAIT(); SWRITE(1, SO); __syncthreads();
  for (int j = 1; j + 1 < NT; j += 2) {
    SBAR(); qkt(pB0, pB1, (bf16*)((char*)K_lds + SHM_K), qr, r32, hi);
    finishSM(pA0, pA1, l_reg, pa0, pa1, pa2, pa3); SBAR();
    SLOAD(SO, (j + 2) * KVBLK); SBAR();
    pv_d0(o, vb0, pa0, pa1, pa2, pa3); partialSM(pB0, pB1, mC);
    __syncthreads(); SWAIT(); SWRITE(0, SE);
    __syncthreads();
    SBAR(); qkt(pA0, pA1, K_lds, qr, r32, hi);
    finishSM(pB0, pB1, l_reg, pa0, pa1, pa2, pa3); SBAR();
    if (j + 3 < NT) SLOAD(SE, (j + 3) * KVBLK); SBAR();
    pv_d0(o, vb0 + (int)SHM_V, pa0, pa1, pa2, pa3); partialSM(pA0, pA1, mC);
    __syncthreads(); SWAIT(); SWRITE(1, SO);
    __syncthreads();
  }
  SBAR(); qkt(pB0, pB1, (bf16*)((char*)K_lds + SHM_K), qr, r32, hi);
  finishSM(pA0, pA1, l_reg, pa0, pa1, pa2, pa3); SBAR();
  pv_d0(o, vb0, pa0, pa1, pa2, pa3); partialSM(pB0, pB1, mC);
  __syncthreads();
  finishSM(pB0, pB1, l_reg, pa0, pa1, pa2, pa3); SBAR();
  pv_d0(o, vb0 + (int)SHM_V, pa0, pa1, pa2, pa3);
  if (hi == 0) li_l[r32] = l_reg; asm volatile("s_waitcnt lgkmcnt(0)" ::: "memory");
  float rli[16];
#pragma unroll
  for (int r = 0; r < 16; ++r) rli[r] = __builtin_amdgcn_rcpf(li_l[crow(r, hi)]);
  unsigned short* Ow = Ob + (long)(wid * QBLK) * LDO;
#pragma unroll
  for (int r = 0; r < 16; ++r) { int orow = crow(r, hi);
    for (int d0 = 0; d0 < 4; ++d0) Ow[(long)orow * LDO + d0 * 32 + r32] = (unsigned short)(cvtpk(o[d0][r] * rli[r], 0.f) & 0xffffu); }
  __syncthreads();
#undef SLOAD
#undef SWRITE
#undef SWAIT
}
}

#define LAS __attribute__((address_space(3)))
typedef unsigned short bf16_t;
typedef float f32x4 __attribute__((ext_vector_type(4)));
typedef unsigned v4u __attribute__((ext_vector_type(4)));
typedef unsigned v2u __attribute__((ext_vector_type(2)));
constexpr size_t MiB = 1u << 20;
constexpr size_t WS_WOUT = 1 * MiB, WS_WQKV = 3 * MiB, WS_WO = 6 * MiB, WS_WUP = 8 * MiB, WS_WDN = 24 * MiB, WS_WC = 40 * MiB, WS_FA = 40 * MiB + 65536, WS_FB = 41 * MiB, WS_SSQ = 42 * MiB  ;
constexpr size_t WS_R1 = 48 * MiB;
constexpr size_t WS_R2 = 240 * MiB;
constexpr size_t WS_YT = WS_R2 + 384 * MiB;
constexpr size_t WS_END = WS_R2 + 768 * MiB;
constexpr int LDS_BYTES = 131072 + 4096;
constexpr int N_PHASES = 14;

__device__ __forceinline__ unsigned f2bf(float f) { unsigned u = __builtin_bit_cast(unsigned, f); return (u + 0x7fffu + ((u >> 16) & 1u)) >> 16; }
__device__ __forceinline__ unsigned pk2(float lo, float hi) { return f2bf(lo) | (f2bf(hi) << 16); }
__device__ __forceinline__ float bf2f(unsigned short b) { return __builtin_bit_cast(float, (unsigned)b << 16); }
__device__ __forceinline__ float wave_sum(float v) {
#pragma unroll
    for (int o = 1; o < 64; o <<= 1) v += __shfl_xor(v, o);
    return v;
}
__device__ __forceinline__ void transpose_item(const float* W, int K, int N, bf16_t* WT, LAS float* scr, int item, int lane, const float* gain = nullptr) {
    const int nblk = N / 32, kb = item / nblk, nb = item % nblk, k0 = 64 * kb, n0 = 32 * nb;
#pragma unroll 8
    for (int i = 0; i < 32; ++i) { const int kk = 2 * i + (lane >> 5); const float gk = gain ? gain[k0 + kk] : 1.0f; scr[kk * 33 + (lane & 31)] = W[(size_t)(k0 + kk) * N + n0 + (lane & 31)] * gk; }
    asm volatile("s_waitcnt lgkmcnt(0)" ::: "memory");
    const int c = lane & 7;
#pragma unroll
    for (int j = 0; j < 4; ++j) { const int n = (lane >> 3) + 8 * j; const LAS float* s = scr + (8 * c) * 33 + n;
        v4u o; o.x = pk2(s[0 * 33], s[1 * 33]); o.y = pk2(s[2 * 33], s[3 * 33]); o.z = pk2(s[4 * 33], s[5 * 33]); o.w = pk2(s[6 * 33], s[7 * 33]);
        *(v4u*)(WT + (size_t)(n0 + n) * K + k0 + 8 * c) = o; }
    asm volatile("s_waitcnt lgkmcnt(0)" ::: "memory");
}
__device__ __forceinline__ void rms_rows_bf16(const float* x0, const float* x1, const float* g, bf16_t* out, int gw, int NGW, int ln) {
    f32x4 gv[4];
#pragma unroll
    for (int j = 0; j < 4; ++j) gv[j] = ((const f32x4*)g)[ln + 64 * j];
    for (int m = gw * 4; m < T; m += NGW * 4) {
        const float* xr = (m < T_PROMPT) ? x0 + (size_t)m * D : x1 + (size_t)(m - T_PROMPT) * D;
        f32x4 v[4][4];
#pragma unroll
        for (int r = 0; r < 4; ++r)
#pragma unroll
            for (int j = 0; j < 4; ++j) v[r][j] = ((const f32x4*)(xr + r * D))[ln + 64 * j];
#pragma unroll
        for (int r = 0; r < 4; ++r) { float s = 0.f;
#pragma unroll
            for (int j = 0; j < 4; ++j) s += (v[r][j].x * v[r][j].x + v[r][j].y * v[r][j].y) + (v[r][j].z * v[r][j].z + v[r][j].w * v[r][j].w);
            const float rs = 1.0f / sqrtf(wave_sum(s) * (1.0f / D) + EPS);
            v2u* o8 = (v2u*)(out + (size_t)(m + r) * D) + ln;
#pragma unroll
            for (int j = 0; j < 4; ++j) { const f32x4 y = v[r][j] * rs * gv[j]; v2u w; w.x = pk2(y.x, y.y); w.y = pk2(y.z, y.w); o8[64 * j] = w; } }
    }
}
__device__ __forceinline__ void rms_rows_final(const bf16_t* xs, const float* g, float* o, int gw, int NGW, int ln) {
    f32x4 gv[2][2];
#pragma unroll
    for (int j = 0; j < 2; ++j) { gv[j][0] = ((const f32x4*)g)[2 * ln + 128 * j]; gv[j][1] = ((const f32x4*)g)[2 * ln + 128 * j + 1]; }
    for (int m = gw * 4; m < T; m += NGW * 4) {
        v4u raw[4][2];
#pragma unroll
        for (int r = 0; r < 4; ++r)
#pragma unroll
            for (int j = 0; j < 2; ++j) raw[r][j] = ((const v4u*)(xs + (size_t)(m + r) * D))[ln + 64 * j];
#pragma unroll
        for (int r = 0; r < 4; ++r) { float x[2][8]; float sq = 0.f;
#pragma unroll
            for (int j = 0; j < 2; ++j)
#pragma unroll
                for (int e = 0; e < 4; ++e) { x[j][2 * e] = __builtin_bit_cast(float, raw[r][j][e] << 16); x[j][2 * e + 1] = __builtin_bit_cast(float, raw[r][j][e] & 0xffff0000u); sq += x[j][2 * e] * x[j][2 * e] + x[j][2 * e + 1] * x[j][2 * e + 1]; }
            const float rs = 1.0f / sqrtf(wave_sum(sq) * (1.0f / D) + EPS);
            f32x4* orow = (f32x4*)(o + (size_t)(m + r) * D);
#pragma unroll
            for (int j = 0; j < 2; ++j) { orow[2 * ln + 128 * j] = (f32x4){x[j][0], x[j][1], x[j][2], x[j][3]} * rs * gv[j][0]; orow[2 * ln + 128 * j + 1] = (f32x4){x[j][4], x[j][5], x[j][6], x[j][7]} * rs * gv[j][1]; } }
    }
}

#define XB_TMO      128
#define XB_XCNT(j)  (256  + 64 * (j))
#define XB_XSUB(j)  (1280 + 64 * (j))
#define XB_XGEN(j)  (2304 + 64 * (j))
#define XB_TOP      3328
#define XB_TOPGEN   3392
#define XCD_BAR_WORDS 3456
#define XB_SPIN_CAP (1u << 18)

__device__ __forceinline__ unsigned xb_ld(unsigned* p)              { return __hip_atomic_load(p, __ATOMIC_RELAXED, __HIP_MEMORY_SCOPE_AGENT); }
__device__ __forceinline__ unsigned xb_add(unsigned* p, unsigned v) { return __hip_atomic_fetch_add(p, v, __ATOMIC_RELAXED, __HIP_MEMORY_SCOPE_AGENT); }
__device__ __forceinline__ unsigned xb_xcc_id() { return (unsigned)__builtin_amdgcn_s_getreg((3 << 11) | 20) & 0xFu; }
#define XB_SPIN(cond, bar) do { unsigned _sp = 0; while (cond) { __builtin_amdgcn_s_sleep(1); \
    if ((++_sp & 255u) == 0u) { if (xb_ld(&(bar)[XB_TMO])) break; if (_sp > XB_SPIN_CAP) { atomicAdd(&(bar)[XB_TMO], 1u); break; } } } } while (0)

struct XcdBarrier {
    unsigned* bar; unsigned x;
    volatile LAS unsigned* st;
};

__device__ __forceinline__ XcdBarrier xcd_barrier_post(unsigned* bar, volatile LAS unsigned* st) {
    XcdBarrier b; b.bar = bar; b.x = xb_xcc_id(); b.st = st;
    if (threadIdx.x == 0) (void)xb_add(&bar[XB_XCNT(b.x)], 1u);
    return b;
}
__device__ __forceinline__ void xcd_barrier_complete(unsigned* bar, unsigned x, unsigned& nloc, unsigned& nx) {
    const unsigned G = gridDim.x * gridDim.y * gridDim.z;
    unsigned sum, cnt, mine, sp = 0u;
    for (;;) {
        sum = 0u; cnt = 0u; mine = 0u;
#pragma unroll
        for (unsigned j = 0; j < 16; ++j) { const unsigned c = xb_ld(&bar[XB_XCNT(j)]); sum += c; cnt += (c > 0u) ? 1u : 0u; mine = (j == x) ? c : mine; }
        if (sum == G) break;
        __builtin_amdgcn_s_sleep(1);
        if ((++sp & 255u) == 0u) { if (xb_ld(&bar[XB_TMO])) break; if (sp > XB_SPIN_CAP) { atomicAdd(&bar[XB_TMO], 1u); break; } }
    }
    nloc = mine > 0u ? mine : 1u; nx = cnt > 0u ? cnt : 1u;
}

__device__ __forceinline__ void xcd_barrier(const XcdBarrier& b) {
    asm volatile("s_waitcnt vmcnt(0)" ::: "memory");
    __syncthreads();
    if (threadIdx.x == 0) {
        unsigned* bar = b.bar;
        __builtin_amdgcn_s_waitcnt(0);
        unsigned nloc = b.st[0], nx = b.st[1];
        if (nloc == 0u) { xcd_barrier_complete(bar, b.x, nloc, nx); b.st[0] = nloc; b.st[1] = nx; }
        const unsigned old = xb_add(&bar[XB_XSUB(b.x)], 1u);
        const unsigned gen = old / nloc;
        if (old + 1u == (gen + 1u) * nloc) {
            __builtin_amdgcn_fence(__ATOMIC_RELEASE, "agent");
            asm volatile("s_waitcnt vmcnt(0)" ::: "memory");
            const unsigned og = xb_add(&bar[XB_TOP], 1u);
            const unsigned tg = og / nx;
            if (og + 1u == (tg + 1u) * nx) xb_add(&bar[XB_TOPGEN], 1u);
            else XB_SPIN(xb_ld(&bar[XB_TOPGEN]) == tg, bar);
            __builtin_amdgcn_fence(__ATOMIC_ACQUIRE, "agent");
            xb_add(&bar[XB_XGEN(b.x)], 1u);
            asm volatile("s_waitcnt vmcnt(0)" ::: "memory");
        } else {
            XB_SPIN(xb_ld(&bar[XB_XGEN(b.x)]) == gen, bar);
            __builtin_amdgcn_fence(__ATOMIC_ACQUIRE, "agent");
            asm volatile("s_waitcnt vmcnt(0)" ::: "memory");
        }
    }
    __syncthreads();
}

struct Args { const float* in[13]; float* out; unsigned char* ws; int ph_lo, ph_hi; };

__global__ void __launch_bounds__(512, 2) fwd_megakernel(Args args) {
    extern __shared__ __attribute__((aligned(16))) unsigned char lds[];
#define TIDX ({ int t_ = threadIdx.x; asm volatile("" : "+v"(t_)); t_; })
#define tid TIDX
#define lane (TIDX & 63)
    const int wave = __builtin_amdgcn_readfirstlane(TIDX >> 6);
    const int G = gridDim.x, cb = blockIdx.x;
    const int gw = cb * 8 + wave, NGW = G * 8;
    unsigned char* ws = args.ws;
    const float* x_prompt = args.in[0]; const float* x_sample = args.in[1];
    const float* fourier_norm = args.in[2]; const float* fourier_w_out = args.in[3];
    const float* attn_norm = args.in[4]; const float* attn_w_qkv = args.in[5]; const float* q_gain = args.in[6]; const float* k_gain = args.in[7];
    const float* attn_w_o = args.in[8]; const float* mlp_norm = args.in[9]; const float* mlp_w_up = args.in[10]; const float* mlp_w_down = args.in[11]; const float* final_norm = args.in[12];
    float* out = args.out;
    bf16_t* WoutT = (bf16_t*)(ws + WS_WOUT); bf16_t* WqkvT = (bf16_t*)(ws + WS_WQKV); bf16_t* WoT = (bf16_t*)(ws + WS_WO);
    bf16_t* WupT = (bf16_t*)(ws + WS_WUP); bf16_t* WdnT = (bf16_t*)(ws + WS_WDN); bf16_t* Wc = (bf16_t*)(ws + WS_WC);
    bf16_t* R1 = (bf16_t*)(ws + WS_R1); bf16_t* R2 = (bf16_t*)(ws + WS_R2); bf16_t* YT = (bf16_t*)(ws + WS_YT); bf16_t* FA = (bf16_t*)(ws + WS_FA); bf16_t* FB = (bf16_t*)(ws + WS_FB); float* SSQ = (float*)(ws + WS_SSQ); bf16_t* OB = YT;
    PG8_LAS unsigned char* glds = (PG8_LAS unsigned char*)lds;
    const int lo = args.ph_lo, hi = args.ph_hi;
    volatile LAS unsigned* MISC = (volatile LAS unsigned*)((LAS unsigned char*)lds + 131072);
    if (tid < 16) MISC[tid] = 0u;
    __syncthreads();
    if (hi > 1000) cg::this_grid().sync();
    XcdBarrier xbar = xcd_barrier_post((unsigned*)ws, MISC + 8);
    int ph = 0;
#define PH_ON (lo <= ph && ph < hi)
#define PH_NEXT do { if (lo <= ph && ph + 1 < hi) xcd_barrier(xbar); ++ph; } while (0)

    if (PH_ON) {
        const long gtid = (long)cb * 512 + tid, NTH = (long)G * 512;
        LAS float* scr = (LAS float*)((LAS unsigned char*)lds + wave * 16384);
        constexpr int I_SQ = (D / 64) * (D / 32), I_QKV = (D / 64) * (QKVD / 32), I_UP = (D / 64) * (FF / 32), I_DN = (FF / 64) * (D / 32);
        constexpr int NITEMS = 2 * I_SQ + I_QKV + 2 * I_UP + 2 * I_DN;
        for (int it = gw; it < NITEMS; it += NGW) {
            int r = it;
            if (r < I_SQ) { transpose_item(fourier_w_out, D, D, WoutT, scr, r, lane); continue; } r -= I_SQ;
            if (r < I_SQ) { transpose_item(attn_w_o, D, D, WoT, scr, r, lane); continue; } r -= I_SQ;
            if (r < I_QKV) { transpose_item(attn_w_qkv, D, QKVD, WqkvT, scr, r, lane, attn_norm); continue; } r -= I_QKV;
            if (r < I_UP) { transpose_item(mlp_w_up, D, FF, WupT, scr, r, lane, mlp_norm); continue; } r -= I_UP;
            if (r < I_UP) { transpose_item(mlp_w_up + (size_t)D * FF, D, FF, WupT + (size_t)D * FF, scr, r, lane, mlp_norm + D); continue; } r -= I_UP;
            if (r < I_DN) { transpose_item(mlp_w_down, FF, D, WdnT, scr, r, lane); continue; } r -= I_DN;
            transpose_item(mlp_w_down + (size_t)D * FF, FF, D, WdnT + (size_t)D * FF, scr, r, lane);
        }
        for (long it = gtid; it < 256 * 128 / 8; it += NTH) {
            const int row = (int)(it >> 4), c0 = (int)(it & 15) * 8, l = row >> 1, ri = row & 1; float v[8];
#pragma unroll
            for (int e = 0; e < 8; ++e) { const float ang = (float)((l * (c0 + e)) & 127) * (1.0f / 64.0f); v[e] = ri ? -sinpif(ang) : cospif(ang); }
            v4u o; o.x = pk2(v[0], v[1]); o.y = pk2(v[2], v[3]); o.z = pk2(v[4], v[5]); o.w = pk2(v[6], v[7]);
            *(v4u*)(Wc + (size_t)row * 128 + c0) = o;
        }
        for (long it = gtid; it < 128 * 128 / 8; it += NTH) {
            const int row = (int)(it >> 4), c0 = (int)(it & 15) * 8, k1 = row >> 1, ro = row & 1, ri = c0 >> 6; float v[8];
#pragma unroll
            for (int e = 0; e < 8; ++e) { const int s1 = (c0 + e) & 63; const float ang = (float)((k1 * s1) & 63) * (1.0f / 32.0f); const float cv = cospif(ang), sv = sinpif(ang);
                v[e] = (ro == ri) ? cv : (ro ? -sv : sv); }
            v4u o; o.x = pk2(v[0], v[1]); o.y = pk2(v[2], v[3]); o.z = pk2(v[4], v[5]); o.w = pk2(v[6], v[7]);
            *(v4u*)(FA + (size_t)row * 128 + c0) = o;
        }
        const float sc = 0.0013810679320049757f;
        for (long it = gtid; it < 64L * 64 * 128 / 8; it += NTH) {
            const int row = (int)(it >> 4), c0 = (int)(it & 15) * 8, k1 = row >> 6, k2 = row & 63, ro = c0 >> 6; float v[8];
#pragma unroll
            for (int e = 0; e < 8; ++e) { const int s2 = (c0 + e) & 63; const float ang = (float)(((k1 + 64 * k2) * s2) & 4095) * (1.0f / 2048.0f); v[e] = (ro ? sinpif(ang) : cospif(ang)) * sc; }
            v4u o; o.x = pk2(v[0], v[1]); o.y = pk2(v[2], v[3]); o.z = pk2(v[4], v[5]); o.w = pk2(v[6], v[7]);
            *(v4u*)(FB + (size_t)row * 128 + c0) = o;
        }
        for (long it = gtid; it < 4L * T / 4; it += NTH) ((f32x4*)SSQ)[it] = (f32x4){0.f, 0.f, 0.f, 0.f};
        rms_rows_bf16(x_prompt, x_sample, fourier_norm, R1, gw, NGW, lane);
    }
    PH_NEXT;
    if (PH_ON) {
        int kk = 128; asm volatile("" : "+s"(kk));
        pg8::Gemm g{kk, 128, D, 128 * 128 * 2, 2 * D * 2, 127, 1, 0}; pg8::SchedChan S{(const char*)Wc, (const char*)R1, G, cb};
        pg8::EpiChan E{R2};
        pg8::gemm_phase(glds, g, S, E);
    }
    PH_NEXT;
    if (PH_ON) {
        int kk = 128; asm volatile("" : "+s"(kk));
        pg8::Gemm g{kk, 128, 128, 0, 128 * 128 * 2, 127, 0, 1}; pg8::SchedLin S{(const char*)FA, (const char*)R2, G, cb, NBATCH * 8 * 128 * 64 / 256, 0, 0};
        pg8::EpiStageA E{YT};
        pg8::gemm_phase(glds, g, S, E);
    }
    PH_NEXT;
    if (PH_ON) {
        int kk = 128; asm volatile("" : "+s"(kk));
        pg8::Gemm g{kk, 128, 128, 0, 128 * 128 * 2, 63, 0, 2}; pg8::SchedLin S{(const char*)FB, (const char*)YT, G, cb, NBATCH * 64 * 8 * 128 / 256, 1, (size_t)64 * 128 * 2};
        pg8::EpiStageB E{R2};
        pg8::gemm_phase(glds, g, S, E);
    }
    PH_NEXT;
    if (PH_ON) {
        pg8::Gemm g = pg8::plain(D, D, D); pg8::SchedMN S{(const char*)R2, (const char*)WoutT, T / 256, D / 256, G, cb, (size_t)256 * D * 2, (size_t)256 * D * 2, D};
        pg8::EpiRes E{x_prompt, x_sample, T_PROMPT / 256, (size_t)T_PROMPT * D, R1, SSQ, D};
        pg8::gemm_phase(glds, g, S, E);
    }
    PH_NEXT;
    if (PH_ON) {
        pg8::Gemm g = pg8::plain(D, D, D); pg8::SchedMN S{(const char*)R1, (const char*)WupT, T / 256, FF / 256, G, cb, (size_t)256 * D * 2, (size_t)256 * D * 2, FF};
        pg8::EpiBf16<2> E{R2, FF, SSQ};
        pg8::gemm_phase(glds, g, S, E);
    }
    PH_NEXT;
    if (PH_ON) {
        pg8::Gemm g = pg8::plain(FF, FF, FF); pg8::SchedMN S{(const char*)R2, (const char*)WdnT, T / 256, D / 256, G, cb, (size_t)256 * FF * 2, (size_t)256 * FF * 2, D};
        pg8::EpiRes E{nullptr, nullptr, 0, 0, R1, SSQ + T, D};
        pg8::gemm_phase(glds, g, S, E);
    }
    PH_NEXT;
    if (PH_ON) {
        pg8::Gemm g = pg8::plain(D, D, D); pg8::SchedMN S{(const char*)R1, (const char*)WqkvT, T / 256, QKVD / 256, G, cb, (size_t)256 * D * 2, (size_t)256 * D * 2, QKVD};
        pg8::EpiBf16<0> E{R2, QKVD, SSQ + T};
        pg8::gemm_phase(glds, g, S, E);
    }
    PH_NEXT;
    if (PH_ON) {
        const int hs = lane >> 4, i16 = lane & 15, axis = i16 >> 3, x2half = (i16 >> 2) & 1, j0 = (i16 & 3) * 8;
        float inv[8], gk[8];
#pragma unroll
        for (int e = 0; e < 8; ++e) { inv[e] = exp2f(-(float)(2 * (j0 + e)) * (1.0f / 64.0f) * 13.287712379549449f) * 0.15915494309189535f;
            gk[e] = k_gain[i16 * 8 + e]; }
        for (int t0 = gw * 8; t0 < T; t0 += NGW * 8) {
            v4u raw[4];
#pragma unroll
            for (int u = 0; u < 4; ++u) raw[u] = *(const v4u*)(R2 + (size_t)(t0 + 2 * u + (hs >> 1)) * QKVD + 1024 + (hs & 1) * 128 + i16 * 8);
#pragma unroll
            for (int u = 0; u < 4; ++u) {
                const int t = t0 + 2 * u + (hs >> 1), sp = t & (SEQ - 1); const float p = (float)(axis ? (sp & 63) : (sp >> 6));
                float x[8];
#pragma unroll
                for (int e = 0; e < 4; ++e) { x[2 * e] = __builtin_bit_cast(float, raw[u][e] << 16); x[2 * e + 1] = __builtin_bit_cast(float, raw[u][e] & 0xffff0000u); }
                float ss = 0.f;
#pragma unroll
                for (int e = 0; e < 8; ++e) ss += x[e] * x[e];
                ss += __shfl_xor(ss, 1); ss += __shfl_xor(ss, 2); ss += __shfl_xor(ss, 4); ss += __shfl_xor(ss, 8);
                const float rs = 1.0f / sqrtf(ss * (1.0f / 128.0f) + EPS);
                float o[8];
#pragma unroll
                for (int e = 0; e < 8; ++e) { const float rev = p * inv[e]; const float cs = __builtin_amdgcn_cosf(rev); float sn = __builtin_amdgcn_sinf(rev); if (!x2half) sn = -sn;
                    const float y = x[e] * rs * gk[e]; const float pr = __shfl_xor(y, 4); o[e] = y * cs + pr * sn; }
                v4u w; w.x = pk2(o[0], o[1]); w.y = pk2(o[2], o[3]); w.z = pk2(o[4], o[5]); w.w = pk2(o[6], o[7]);
                *(v4u*)(R2 + (size_t)t * QKVD + 1024 + (hs & 1) * 128 + i16 * 8) = w;
            }
        }
    }
    PH_NEXT;
    if (PH_ON) {
        const int rounds = (NBATCH * 8 * 16 + G - 1) / G;
        float gqm = fmaxf(fabsf(q_gain[lane]), fabsf(q_gain[lane + 64])), gkm = fmaxf(fabsf(k_gain[lane]), fabsf(k_gain[lane + 64]));
#pragma unroll
        for (int o_ = 1; o_ < 64; o_ <<= 1) { gqm = fmaxf(gqm, __shfl_xor(gqm, o_)); gkm = fmaxf(gkm, __shfl_xor(gkm, o_)); }
        const float mC = -(128.0f * gqm * gkm * 1.02f) * (attn::SCALE * 1.4426950408889634f);
        for (int i = 0; i < rounds; ++i) {
            int b, h, qb;
            if (G == 256) { const int x = cb & 7, sl = cb >> 3; b = 2 * i + (x >> 2); const int kvh = (x >> 1) & 1; h = kvh * 4 + (x & 1) * 2 + (sl >> 4); qb = sl & 15; }
            else { const int u = i * G + cb; if (u >= NBATCH * 8 * 16) break; b = u >> 7; h = (u >> 4) & 7; qb = u & 15; }
            const int kvh = h >> 2;
            const attn::bf16* base = (const attn::bf16*)R2 + (size_t)b * SEQ * QKVD;
            attn::attn_dense_body(base + (size_t)qb * 256 * QKVD + h * 128, base + 1024 + kvh * 128, base + 1280 + kvh * 128,
                                  OB + ((size_t)b * SEQ + (size_t)qb * 256) * D + h * 128, SEQ, (char*)lds, q_gain, qb * 256, mC);
        }
    }
    PH_NEXT;
    if (PH_ON) {
        pg8::Gemm g = pg8::plain(D, D, D); pg8::SchedMN S{(const char*)OB, (const char*)WoT, T / 256, D / 256, G, cb, (size_t)256 * D * 2, (size_t)256 * D * 2, D};
        pg8::EpiRes E{nullptr, nullptr, 0, 0, R1, SSQ + 2 * T, D};
        pg8::gemm_phase(glds, g, S, E);
    }
    PH_NEXT;
    if (PH_ON) {
        pg8::Gemm g = pg8::plain(D, D, D); pg8::SchedMN S{(const char*)R1, (const char*)(WupT + (size_t)D * FF), T / 256, FF / 256, G, cb, (size_t)256 * D * 2, (size_t)256 * D * 2, FF};
        pg8::EpiBf16<2> E{R2, FF, SSQ + 2 * T};
        pg8::gemm_phase(glds, g, S, E);
    }
    PH_NEXT;
    if (PH_ON) {
        pg8::Gemm g = pg8::plain(FF, FF, FF); pg8::SchedMN S{(const char*)R2, (const char*)(WdnT + (size_t)D * FF), T / 256, D / 256, G, cb, (size_t)256 * FF * 2, (size_t)256 * FF * 2, D};
        pg8::EpiRes E{nullptr, nullptr, 0, 0, R1, SSQ + 3 * T, D};
        pg8::gemm_phase(glds, g, S, E);
    }
    PH_NEXT;
    if (PH_ON) rms_rows_final(R1, final_norm, out, gw, NGW, lane);
#undef PH_ON
#undef PH_NEXT
#undef tid
#undef lane
}

extern "C" void kernel_launch(void* const* d_in, const int* in_sizes, int n_in, void* d_out, int out_size, void* d_ws, size_t ws_size, hipStream_t stream) {
    static int grid = 0;
    if (grid == 0) {
        if (n_in != 13 || out_size != T * D || ws_size < WS_END) { fprintf(stderr, "kernel_launch: shape/workspace mismatch (n_in %d out %d ws %zu, need %zu)\n", n_in, out_size, ws_size, (size_t)WS_END); grid = -1; return; }
        int dev = 0, cus = 0, per_cu = 0;
        if (hipGetDevice(&dev) != hipSuccess || hipDeviceGetAttribute(&cus, hipDeviceAttributeMultiprocessorCount, dev) != hipSuccess) { grid = -1; return; }
        if (hipFuncSetAttribute((const void*)fwd_megakernel, hipFuncAttributeMaxDynamicSharedMemorySize, LDS_BYTES) != hipSuccess) { fprintf(stderr, "kernel_launch: hipFuncSetAttribute failed\n"); grid = -1; return; }
        if (hipOccupancyMaxActiveBlocksPerMultiprocessor(&per_cu, (const void*)fwd_megakernel, 512, LDS_BYTES) != hipSuccess || per_cu < 1) { fprintf(stderr, "kernel_launch: occupancy query says %d\n", per_cu); per_cu = 1; }
        (void)hipGetLastError();
        grid = cus;
    }
    if (grid < 0) return;
    (void)hipMemsetAsync(d_ws, 0, 16384, stream);
    Args a{};
    for (int i = 0; i < 13; ++i) a.in[i] = (const float*)d_in[i];
    a.out = (float*)d_out; a.ws = (unsigned char*)d_ws;
#if MK_PER_PHASE
    for (int p = 0; p < N_PHASES; ++p) { a.ph_lo = p; a.ph_hi = p + 1; hipLaunchKernelGGL(fwd_megakernel, dim3(grid), dim3(512), LDS_BYTES, stream, a); }
#else
    a.ph_lo = 0; a.ph_hi = N_PHASES;
    void* kargs[] = {&a};
    hipError_t e = hipLaunchCooperativeKernel((const void*)fwd_megakernel, dim3(grid), dim3(512), kargs, LDS_BYTES, stream);
    if (e != hipSuccess) fprintf(stderr, "kernel_launch: cooperative launch failed: %s (grid %d)\n", hipGetErrorString(e), grid);
#endif
}
```

```cpp
#include <hip/hip_runtime.h>
#include <hip/hip_bf16.h>
#include <hip/hip_cooperative_groups.h>
#include <cstdio>
#include <cstdint>
namespace cg = cooperative_groups;

#ifndef MK_PER_PHASE
#define MK_PER_PHASE 0
#endif

constexpr int D = 1024, SEQ = 4096, NBATCH = 24, T = NBATCH * SEQ;
constexpr int T_PROMPT = 8 * SEQ;
constexpr int FF = 4096, QKVD = 1536;
constexpr float EPS = 1e-6f;

#ifndef PG8_ALIGN
#define PG8_ALIGN 1
#endif
#ifndef PG8_SP2
#define PG8_SP2 1
#endif
namespace pg8 {
#define PG8_LAS __attribute__((address_space(3)))
typedef unsigned short bf16_t;
typedef short bf16x8 __attribute__((ext_vector_type(8)));
typedef float f32x4 __attribute__((ext_vector_type(4)));
typedef unsigned u32x4 __attribute__((ext_vector_type(4)));
constexpr int BM = 256, BK = 64, HALF = 128, HTB = HALF * BK * 2, STAGE_BYTES = 8 * HTB, NXCD = 8, WGM = 8;

__host__ __device__ __forceinline__ int lds_byte(int r, int c) { const int st = (r >> 4) * 2 + (c >> 5), rr = r & 15, cc = c & 31, ob = rr * 64 + cc * 2; return st * 1024 + (ob ^ (((ob >> 9) & 1) << 5)); }
__host__ __device__ __forceinline__ void stage_rc(int b, int& R, int& C) { const int st = b / 1024, sb = b % 1024, swz = sb ^ (((sb >> 9) & 1) << 5); R = (st >> 1) * 16 + swz / 64; C = (st & 1) * 32 + (swz % 64) / 2; }
__host__ __device__ __forceinline__ int perm32(int rho) { const int n = rho >> 4, i = rho & 15; return 8 * (i >> 2) + 4 * n + (i & 3); }

struct Unit { int pm, pn; const char* a; const char* b; size_t c; };
struct Gemm { int K, lda, ldb; unsigned hsA, hsB; int amask, bmode; int skip; };
__device__ __forceinline__ Gemm plain(int K, int lda, int ldb) { return Gemm{K, lda, ldb, (unsigned)(HALF * lda * 2), (unsigned)(HALF * ldb * 2), 127, 0, 0}; }

__device__ __forceinline__ bool tile_decode(int i, int G, int c, int nM, int nN, int& pm, int& pn) {
    const int nwg = nM * nN; const long L = (long)i * G + c; if (L >= nwg) return false;
    int wgid = (int)L; { const int q = nwg / NXCD, r = nwg % NXCD, xcd = wgid % NXCD, off = wgid / NXCD; wgid = (xcd < r ? xcd * (q + 1) : r * (q + 1) + (xcd - r) * q) + off; }
    const int nig = WGM * nN, gid = wgid / nig, fm = gid * WGM, gsz = (nM - fm) < WGM ? (nM - fm) : WGM;
    pm = fm + ((wgid % nig) % gsz); pn = (wgid % nig) / gsz; return true;
}
struct SchedMN {
    const char* A; const char* B; int nM, nN, G, c; size_t a_tile, b_tile; int ldc;
    __device__ __forceinline__ bool next(int i, Unit& u) const {
        if (!tile_decode(i, G, c, nM, nN, u.pm, u.pn)) return false;
        u.a = A + (size_t)u.pm * a_tile; u.b = B + (size_t)u.pn * b_tile; u.c = (size_t)u.pm * BM * ldc + (size_t)u.pn * BM; return true;
    }
};
struct SchedChan {
    const char* A; const char* B; int G, c;
    __device__ __forceinline__ bool next(int i, Unit& u) const {
        if (!tile_decode(i, G, c, NBATCH * 8, SEQ / BM, u.pm, u.pn)) return false;
        u.a = A; u.b = B + (((size_t)(u.pm >> 3) * SEQ + (size_t)u.pn * 4) * D + (size_t)(u.pm & 7) * 128) * 2; u.c = 0; return true;
    }
};
struct SchedLin {
    const char* A; const char* B; int G, c; int nN; int a_shift; size_t a_stride;
    __device__ __forceinline__ bool next(int i, Unit& u) const {
        if (!tile_decode(i, G, c, 1, nN, u.pm, u.pn)) return false;
        u.a = a_shift ? A + (size_t)((u.pn >> 2) & 63) * a_stride : A; u.b = B + (size_t)u.pn * BM * 128 * 2; u.c = 0; return true;
    }
};

__device__ __forceinline__ unsigned cvt_pk_bf16(float lo, float hi) { unsigned r; asm volatile("v_cvt_pk_bf16_f32 %0, %1, %2" : "=v"(r) : "v"(lo), "v"(hi)); return r; }

template <int ACT  > struct EpiBf16 {
    static constexpr bool PERM = true;
    bf16_t* O; int ldc; const float* ssq;
    struct Pre { float v[2][4]; };
    __device__ __forceinline__ Pre prefetch(const Unit& u, int wr, int fr) const {
        Pre p;
#pragma unroll
        for (int ai = 0; ai < 2; ++ai)
#pragma unroll
            for (int m = 0; m < 4; ++m) p.v[ai][m] = ssq ? ssq[u.pm * BM + wr * 64 + fr + ai * HALF + m * 16] : 0.f;
        return p;
    }
    __device__ __forceinline__ void operator()(const f32x4 (&acc)[2][2][4][2], const Unit& u, int wr, int wc, int fr, int fq, const Pre& pre) const {
        bf16_t* base = O + u.c + (size_t)(wr * 64 + fr) * ldc + wc * 32 + 8 * fq;
        float rs[2][4];
#pragma unroll
        for (int ai = 0; ai < 2; ++ai)
#pragma unroll
            for (int m = 0; m < 4; ++m) rs[ai][m] = ssq ? 1.0f / sqrtf(pre.v[ai][m] * (1.0f / 1024.0f) + 1e-6f) : 1.0f;
#pragma unroll
        for (int ai = 0; ai < 2; ++ai)
#pragma unroll
            for (int m = 0; m < 4; ++m) { bf16_t* rowp = base + (size_t)(ai * HALF + m * 16) * ldc;
#pragma unroll
                for (int bj = 0; bj < 2; ++bj) { f32x4 v0 = acc[ai][bj][m][0] * rs[ai][m], v1 = acc[ai][bj][m][1] * rs[ai][m];
                    if (ACT == 2) {
#pragma unroll
                        for (int e = 0; e < 4; ++e) { const float a0 = fmaxf(v0[e], 0.f), a1 = fmaxf(v1[e], 0.f); v0[e] = a0 * a0; v1[e] = a1 * a1; } }
                    u32x4 w; w.x = cvt_pk_bf16(v0[0], v0[1]); w.y = cvt_pk_bf16(v0[2], v0[3]); w.z = cvt_pk_bf16(v1[0], v1[1]); w.w = cvt_pk_bf16(v1[2], v1[3]);
                    *(u32x4*)(rowp + bj * HALF) = w; } }
    }
};
struct EpiRes {
    static constexpr bool PERM = true;
    struct Pre {}; __device__ __forceinline__ Pre prefetch(const Unit&, int, int) const { return Pre{}; }
    const float* res0; const float* res1; int split_pm; size_t split_off;
    bf16_t* xs; float* ssq; int ldc;
    __device__ __forceinline__ void operator()(const f32x4 (&acc)[2][2][4][2], const Unit& u, int wr, int wc, int fr, int fq, const Pre&) const {
        const float* rb = res0 ? ((u.pm < split_pm) ? res0 + u.c : res1 + (u.c - split_off)) : nullptr;
        bf16_t* xbt = xs + u.c; float* sqt = ssq + u.pm * BM;
        unsigned off0 = (unsigned)((wr * 64 + fr) * ldc + wc * 32 + 8 * fq), roff = (unsigned)(wr * 64 + fr);
        asm volatile("" : "+v"(off0), "+v"(roff));
        if (res0) {
#pragma unroll
            for (int am = 0; am < 4; ++am) { const int ai = am >> 1, mb = (am & 1) * 2;
                f32x4 rr[4][2][2];
#pragma unroll
                for (int m = mb; m < mb + 2; ++m)
#pragma unroll
                    for (int bj = 0; bj < 2; ++bj) { const unsigned o = off0 + (unsigned)((ai * HALF + m * 16) * ldc) + bj * HALF; rr[m][bj][0] = *(const f32x4*)(rb + o); rr[m][bj][1] = *(const f32x4*)(rb + o + 4); }
                asm volatile("" ::: "memory");
#pragma unroll
                for (int m = mb; m < mb + 2; ++m) { const unsigned off = off0 + (unsigned)((ai * HALF + m * 16) * ldc); float sq = 0.f;
#pragma unroll
                    for (int bj = 0; bj < 2; ++bj) {
                        const f32x4 x0 = rr[m][bj][0] + acc[ai][bj][m][0], x1 = rr[m][bj][1] + acc[ai][bj][m][1];
                        sq += ((x0[0] * x0[0] + x0[1] * x0[1]) + (x0[2] * x0[2] + x0[3] * x0[3])) + ((x1[0] * x1[0] + x1[1] * x1[1]) + (x1[2] * x1[2] + x1[3] * x1[3]));
                        u32x4 w; w.x = cvt_pk_bf16(x0[0], x0[1]); w.y = cvt_pk_bf16(x0[2], x0[3]); w.z = cvt_pk_bf16(x1[0], x1[1]); w.w = cvt_pk_bf16(x1[2], x1[3]);
                        *(u32x4*)(xbt + off + bj * HALF) = w; }
                    sq += __shfl_xor(sq, 16); sq += __shfl_xor(sq, 32); if (fq == 0) atomicAdd(sqt + roff + (unsigned)(ai * HALF + m * 16), sq); }
                asm volatile("" ::: "memory"); }
        } else {
#pragma unroll
            for (int ai = 0; ai < 2; ++ai) {
                u32x4 raw[4][2];
#pragma unroll
                for (int m = 0; m < 4; ++m)
#pragma unroll
                    for (int bj = 0; bj < 2; ++bj) raw[m][bj] = *(const u32x4*)(xbt + off0 + (unsigned)((ai * HALF + m * 16) * ldc) + bj * HALF);
                asm volatile("" ::: "memory");
#pragma unroll
                for (int m = 0; m < 4; ++m) { const unsigned off = off0 + (unsigned)((ai * HALF + m * 16) * ldc); float sq = 0.f;
#pragma unroll
                    for (int bj = 0; bj < 2; ++bj) { const u32x4 w = raw[m][bj];
                        const f32x4 x0 = (f32x4){__builtin_bit_cast(float, w.x << 16), __builtin_bit_cast(float, w.x & 0xffff0000u), __builtin_bit_cast(float, w.y << 16), __builtin_bit_cast(float, w.y & 0xffff0000u)} + acc[ai][bj][m][0];
                        const f32x4 x1 = (f32x4){__builtin_bit_cast(float, w.z << 16), __builtin_bit_cast(float, w.z & 0xffff0000u), __builtin_bit_cast(float, w.w << 16), __builtin_bit_cast(float, w.w & 0xffff0000u)} + acc[ai][bj][m][1];
                        sq += ((x0[0] * x0[0] + x0[1] * x0[1]) + (x0[2] * x0[2] + x0[3] * x0[3])) + ((x1[0] * x1[0] + x1[1] * x1[1]) + (x1[2] * x1[2] + x1[3] * x1[3]));
                        u32x4 v; v.x = cvt_pk_bf16(x0[0], x0[1]); v.y = cvt_pk_bf16(x0[2], x0[3]); v.z = cvt_pk_bf16(x1[0], x1[1]); v.w = cvt_pk_bf16(x1[2], x1[3]);
                        *(u32x4*)(xbt + off + bj * HALF) = v; }
                    sq += __shfl_xor(sq, 16); sq += __shfl_xor(sq, 32); if (fq == 0) atomicAdd(sqt + roff + (unsigned)(ai * HALF + m * 16), sq); }
                asm volatile("" ::: "memory"); }
        }
    }
};
__device__ __forceinline__ void store8(bf16_t* p, const f32x4& v0, const f32x4& v1) {
    u32x4 w; w.x = cvt_pk_bf16(v0[0], v0[1]); w.y = cvt_pk_bf16(v0[2], v0[3]); w.z = cvt_pk_bf16(v1[0], v1[1]); w.w = cvt_pk_bf16(v1[2], v1[3]); *(u32x4*)p = w;
}
struct EpiChan {
    static constexpr bool PERM = true;
    struct Pre {}; __device__ __forceinline__ Pre prefetch(const Unit&, int, int) const { return Pre{}; }
    bf16_t* O;
    __device__ __forceinline__ void operator()(const f32x4 (&acc)[2][2][4][2], const Unit& u, int wr, int wc, int fr, int fq, const Pre&) const {
#pragma unroll
        for (int ai = 0; ai < 2; ++ai)
#pragma unroll
            for (int m = 0; m < 4; ++m) { const int r = ai * HALF + wr * 64 + m * 16 + fr, l = r >> 1, ri = r & 1;
#pragma unroll
                for (int bj = 0; bj < 2; ++bj) { const int nl = bj * HALF + wc * 32 + 8 * fq, s2 = 4 * u.pn + (nl >> 6), s1 = nl & 63;
                    store8(O + ((((size_t)u.pm * 128 + l) * 64 + s2) * 2 + ri) * 64 + s1, acc[ai][bj][m][0], acc[ai][bj][m][1]); } }
    }
};
struct EpiStageA {
    static constexpr bool PERM = true;
    struct Pre {}; __device__ __forceinline__ Pre prefetch(const Unit&, int, int) const { return Pre{}; }
    bf16_t* O;
    __device__ __forceinline__ void operator()(const f32x4 (&acc)[2][2][4][2], const Unit& u, int wr, int wc, int fr, int fq, const Pre&) const {
        const int z = u.pn >> 5, l0 = (u.pn & 31) * 4, b = z >> 3, g = z & 7;
#pragma unroll
        for (int m = 0; m < 4; ++m) { const int r = wr * 64 + m * 16 + fr, k1 = r >> 1, ro = r & 1;
#pragma unroll
            for (int bj = 0; bj < 2; ++bj) { const int nl = bj * HALF + wc * 32 + 8 * fq, l = l0 + (nl >> 6), s2 = nl & 63;
                store8(O + ((((size_t)(b * 64 + k1) * 8 + g) * 128 + l) * 2 + ro) * 64 + s2, acc[0][bj][m][0], acc[0][bj][m][1]); } }
    }
};
struct EpiStageB {
    static constexpr bool PERM = true;
    struct Pre {}; __device__ __forceinline__ Pre prefetch(const Unit&, int, int) const { return Pre{}; }
    bf16_t* O;
    __device__ __forceinline__ void operator()(const f32x4 (&acc)[2][2][4][2], const Unit& u, int wr, int wc, int fr, int fq, const Pre&) const {
        if (wr != 0) return;
        const int bk = u.pn >> 2, b = bk >> 6, k1 = bk & 63, ch0 = (u.pn & 3) * 256;
#pragma unroll
        for (int m = 0; m < 4; ++m) { const int k2 = m * 16 + fr;
#pragma unroll
            for (int bj = 0; bj < 2; ++bj) { const int nl = bj * HALF + wc * 32 + 8 * fq;
                store8(O + ((size_t)b * SEQ + k1 + 64 * k2) * D + ch0 + nl, acc[0][bj][m][0], acc[0][bj][m][1]); } }
    }
};

template <class Epi, class Sched>
__device__ __forceinline__ void gemm_phase(PG8_LAS unsigned char* lds, const Gemm g, const Sched& S, const Epi& E) {
    const int tid = threadIdx.x, wid = __builtin_amdgcn_readfirstlane(tid >> 6), lane = tid & 63, wr = wid >> 2, wc = wid & 3, fr = lane & 15, fq = lane >> 4;
    const int K = g.K, nt = K / BK;
    const bool do1 = (g.skip == 0), do0 = (g.skip < 2) || (wr == 0);
    unsigned voffA[2], voffB[2];
#pragma unroll
    for (int i = 0; i < 2; ++i) { int R, C; stage_rc(tid * 16 + i * 8192, R, C); const int Rb = Epi::PERM ? ((R & ~31) + perm32(R & 31)) : R;
        const int Rbm = g.bmode ? ((Rb & 63) * 64 + (Rb >> 6)) : Rb;
        voffA[i] = (unsigned)((R & g.amask) * g.lda + C) * 2u; voffB[i] = (unsigned)(Rbm * g.ldb + C) * 2u; }
    const size_t kstep = (size_t)(BK * 2);
    const size_t hstepA = g.hsA, hstepB = g.hsB;
    const unsigned ldsw = (unsigned)wid * 1024u;
    const int aoff = lds_byte(wr * 64 + fr, fq * 8), boff = lds_byte(wc * 32 + fr, fq * 8);
#define PG8_SA(b, h) (((b) * 2 + (h)) * HTB)
#define PG8_SB(b, h) ((4 + (b) * 2 + (h)) * HTB)
#define PG8_STAGE(bufoff, gbase, voff) do { _Pragma("unroll") for (int _i = 0; _i < 2; ++_i) \
        __builtin_amdgcn_global_load_lds((const unsigned*)((const char*)(gbase) + (voff)[_i]), (PG8_LAS unsigned*)(lds + (bufoff) + ldsw + _i * 8192), 16, 0, 0); } while (0)
#define PG8_LDA(dst, b, h) do { _Pragma("unroll") for (int m = 0; m < 4; ++m) _Pragma("unroll") for (int k = 0; k < 2; ++k) dst[m][k] = *(const PG8_LAS bf16x8*)(lds + PG8_SA(b, h) + aoff + m * 2048 + k * 1024); } while (0)
#define PG8_LDB(dst, b, h) do { _Pragma("unroll") for (int n = 0; n < 2; ++n) _Pragma("unroll") for (int k = 0; k < 2; ++k) dst[n][k] = *(const PG8_LAS bf16x8*)(lds + PG8_SB(b, h) + boff + n * 2048 + k * 1024); } while (0)
#define PG8_MMA(ai, bj, At, Bt) do { __builtin_amdgcn_s_setprio(1); _Pragma("unroll") for (int m = 0; m < 4; ++m) _Pragma("unroll") for (int n = 0; n < 2; ++n) _Pragma("unroll") for (int k = 0; k < 2; ++k) \
        acc[ai][bj][m][n] = __builtin_amdgcn_mfma_f32_16x16x32_bf16(Bt[n][k], At[m][k], acc[ai][bj][m][n], 0, 0, 0); __builtin_amdgcn_s_setprio(0); } while (0)
#define PG8_WAIT_V(n) asm volatile("s_waitcnt vmcnt(" #n ")" ::: "memory")
#define PG8_WAIT_L(n) asm volatile("s_waitcnt lgkmcnt(" #n ")" ::: "memory")
#define PG8_BAR __builtin_amdgcn_s_barrier()
#define PG8_SCHED __builtin_amdgcn_sched_barrier(0)
    Unit cur, nxt; int ui = 0;
    if (!S.next(0, cur)) return;
    f32x4 acc[2][2][4][2];
#pragma unroll
    for (int a = 0; a < 2; ++a)
#pragma unroll
        for (int b = 0; b < 2; ++b)
#pragma unroll
            for (int m = 0; m < 4; ++m)
#pragma unroll
                for (int n = 0; n < 2; ++n) acc[a][b][m][n] = (f32x4){0.f, 0.f, 0.f, 0.f};
    bf16x8 At[4][2], B0[2][2], B1[2][2];
    const char* cA = cur.a; const char* cB = cur.b;
    typename Epi::Pre pre = E.prefetch(cur, wr, fr);
#if PG8_SP2
    PG8_STAGE(PG8_SB(0, 0), cB, voffB); PG8_STAGE(PG8_SB(0, 1), cB + hstepB, voffB); PG8_STAGE(PG8_SA(0, 0), cA, voffA); PG8_STAGE(PG8_SA(0, 1), cA + hstepA, voffA);
    if (wr == 1) PG8_BAR;
    PG8_WAIT_V(2); PG8_BAR;
    PG8_STAGE(PG8_SB(1, 0), cB + kstep, voffB); PG8_STAGE(PG8_SA(1, 0), cA + kstep, voffA); PG8_STAGE(PG8_SB(1, 1), cB + hstepB + kstep, voffB);
    PG8_WAIT_V(6); PG8_BAR;
#else
    PG8_STAGE(PG8_SB(0, 0), cB, voffB); PG8_STAGE(PG8_SA(0, 0), cA, voffA); PG8_STAGE(PG8_SB(0, 1), cB + hstepB, voffB); PG8_STAGE(PG8_SA(0, 1), cA + hstepA, voffA);
    if (wr == 1) PG8_BAR;
    PG8_WAIT_V(4); PG8_BAR;
    PG8_STAGE(PG8_SB(1, 0), cB + kstep, voffB); PG8_STAGE(PG8_SA(1, 0), cA + kstep, voffA); PG8_STAGE(PG8_SB(1, 1), cB + hstepB + kstep, voffB);
    PG8_WAIT_V(6); PG8_BAR;
#endif
    for (;;) {
        const bool has_next = S.next(ui + 1, nxt);
        const char* nA = has_next ? nxt.a : cA; const char* nB = has_next ? nxt.b : cB;
        for (int t = 0; t < nt; t += 2) {
            const bool last = (t == nt - 2);
            const char* a1 = cA + (size_t)(t + 1) * kstep;
            const char* a2 = last ? nA : cA + (size_t)(t + 2) * kstep; const char* b2 = last ? nB : cB + (size_t)(t + 2) * kstep;
            const char* a3 = a2 + kstep; const char* b3 = b2 + kstep;
#if PG8_SP2
            PG8_LDB(B0, 0, 0); PG8_LDB(B1, 0, 1); PG8_SCHED; PG8_LDA(At, 0, 0); PG8_STAGE(PG8_SA(1, 1), a1 + hstepA, voffA);
            PG8_WAIT_V(8); PG8_WAIT_L(0); PG8_BAR; if (do0) { PG8_MMA(0, 0, At, B0); PG8_MMA(0, 1, At, B1); } PG8_BAR; PG8_SCHED;
            PG8_LDA(At, 0, 1); PG8_STAGE(PG8_SB(0, 0), b2, voffB); PG8_STAGE(PG8_SB(0, 1), b2 + hstepB, voffB); PG8_STAGE(PG8_SA(0, 0), a2, voffA);
            PG8_WAIT_V(8); PG8_WAIT_L(0); PG8_BAR; if (do1) { PG8_MMA(1, 0, At, B0); PG8_MMA(1, 1, At, B1); } PG8_BAR; PG8_SCHED;
            PG8_LDB(B0, 1, 0); PG8_LDB(B1, 1, 1); PG8_SCHED; PG8_LDA(At, 1, 0); PG8_STAGE(PG8_SA(0, 1), a2 + hstepA, voffA);
            PG8_WAIT_V(8); PG8_WAIT_L(0); PG8_BAR; if (do0) { PG8_MMA(0, 0, At, B0); PG8_MMA(0, 1, At, B1); } PG8_BAR; PG8_SCHED;
            PG8_LDA(At, 1, 1); PG8_STAGE(PG8_SB(1, 0), b3, voffB); PG8_STAGE(PG8_SB(1, 1), b3 + hstepB, voffB); PG8_STAGE(PG8_SA(1, 0), a3, voffA);
            PG8_WAIT_V(8); PG8_WAIT_L(0); PG8_BAR; if (do1) { PG8_MMA(1, 0, At, B0); PG8_MMA(1, 1, At, B1); } PG8_BAR; PG8_SCHED;
#else
            PG8_LDB(B0, 0, 0); PG8_SCHED; PG8_LDA(At, 0, 0); PG8_STAGE(PG8_SA(1, 1), a1 + hstepA, voffA);
            PG8_WAIT_L(8); PG8_BAR; PG8_WAIT_L(0); PG8_MMA(0, 0, At, B0); PG8_BAR; PG8_SCHED;
            PG8_LDB(B1, 0, 1); PG8_STAGE(PG8_SB(0, 0), b2, voffB);
            PG8_BAR; PG8_WAIT_L(0); PG8_MMA(0, 1, At, B1); PG8_BAR;
            PG8_LDA(At, 0, 1); PG8_STAGE(PG8_SA(0, 0), a2, voffA);
            PG8_BAR; PG8_WAIT_L(0); PG8_MMA(1, 0, At, B0); PG8_BAR; PG8_SCHED;
            PG8_STAGE(PG8_SB(0, 1), b2 + hstepB, voffB);
            PG8_WAIT_V(6); PG8_BAR; PG8_MMA(1, 1, At, B1); PG8_BAR;
            PG8_LDB(B0, 1, 0); PG8_SCHED; PG8_LDA(At, 1, 0); PG8_STAGE(PG8_SA(0, 1), a2 + hstepA, voffA);
            PG8_WAIT_L(8); PG8_BAR; PG8_WAIT_L(0); PG8_MMA(0, 0, At, B0); PG8_BAR; PG8_SCHED;
            PG8_LDB(B1, 1, 1); PG8_STAGE(PG8_SB(1, 0), b3, voffB);
            PG8_BAR; PG8_WAIT_L(0); PG8_MMA(0, 1, At, B1); PG8_BAR;
            PG8_LDA(At, 1, 1); PG8_STAGE(PG8_SA(1, 0), a3, voffA);
            PG8_BAR; PG8_WAIT_L(0); PG8_MMA(1, 0, At, B0); PG8_BAR; PG8_SCHED;
            PG8_STAGE(PG8_SB(1, 1), b3 + hstepB, voffB);
            PG8_WAIT_V(6); PG8_BAR; PG8_MMA(1, 1, At, B1); PG8_BAR;
#endif
        }
#if PG8_ALIGN
        if (wr == 0) PG8_BAR;
#endif
        E(acc, cur, wr, wc, fr, fq, pre);
        if (!has_next) break;
#pragma unroll
        for (int a = 0; a < 2; ++a)
#pragma unroll
            for (int b = 0; b < 2; ++b)
#pragma unroll
                for (int m = 0; m < 4; ++m)
#pragma unroll
                    for (int n = 0; n < 2; ++n) acc[a][b][m][n] = (f32x4){0.f, 0.f, 0.f, 0.f};
        cur = nxt; cA = nA; cB = nB; ++ui;
        pre = E.prefetch(cur, wr, fr);
#if PG8_ALIGN
        if (wr == 1) PG8_BAR;
#endif
    }
    PG8_WAIT_V(0);
#if !PG8_ALIGN
    if (wr == 0) PG8_BAR;
#endif
    PG8_BAR;
#undef PG8_SA
#undef PG8_SB
#undef PG8_STAGE
#undef PG8_LDA
#undef PG8_LDB
#undef PG8_MMA
#undef PG8_WAIT_V
#undef PG8_WAIT_L
#undef PG8_BAR
#undef PG8_SCHED
}
}

namespace attn {
using bf16 = __hip_bfloat16;
constexpr int HD = 128, NW = 8, QBLK = 32, KVBLK = 64;
constexpr float SCALE = 0.088388347648318440f;
constexpr float THR = 8.f;
constexpr int LDQ = QKVD, LDK = QKVD, LDO = D;
constexpr size_t SHM_V = KVBLK * HD * 2, SHM_K = KVBLK * HD * 2, SHM_ATTN = 2 * SHM_V + 2 * SHM_K + NW * 64 * 4;
using bf16x8 = __attribute__((ext_vector_type(8))) short;
using s16x4  = __attribute__((ext_vector_type(4))) short;
using f32x16 = __attribute__((ext_vector_type(16))) float;
using u32x4  = __attribute__((ext_vector_type(4))) unsigned;
#define KSWZ(row, colB) ((row) * 256 + ((colB) ^ (((row) & 7) << 4)))
#define SBAR() __builtin_amdgcn_sched_barrier(0)
__device__ __forceinline__ int crow(int r, int hi) { return (r & 3) + 8 * (r >> 2) + 4 * hi; }
__device__ __forceinline__ unsigned cvtpk(float lo, float hi) { unsigned r; asm volatile("v_cvt_pk_bf16_f32 %0, %1, %2" : "=v"(r) : "v"(lo), "v"(hi)); return r; }
__device__ __forceinline__ bf16x8 ld8(const bf16* p) { return *reinterpret_cast<const bf16x8*>(p); }

__device__ __forceinline__ void partialSM(f32x16& p0, f32x16& p1, float mC) {
  constexpr float C = SCALE * 1.4426950408889634f;
  for (int r = 0; r < 16; ++r) p0[r] = fmaf(p0[r], C, mC); for (int r = 0; r < 16; ++r) p1[r] = fmaf(p1[r], C, mC);
  for (int r = 0; r < 16; ++r) p0[r] = __builtin_amdgcn_exp2f(p0[r]);
}
__device__ __forceinline__ void finishSM(f32x16& p0, f32x16& p1, float& l_reg, bf16x8& pa0, bf16x8& pa1, bf16x8& pa2, bf16x8& pa3) {
  for (int r = 0; r < 16; ++r) p1[r] = __builtin_amdgcn_exp2f(p1[r]);
  float ps = 0; for (int r = 0; r < 16; ++r) ps += p0[r]; for (int r = 0; r < 16; ++r) ps += p1[r];
  { auto rr = __builtin_amdgcn_permlane32_swap(__float_as_uint(ps), __float_as_uint(ps), false, false);
    ps = __uint_as_float(rr[0]) + __uint_as_float(rr[1]); }
  l_reg += ps;
#define PK4(P, BASE, OUT) do { unsigned a0 = cvtpk(P[BASE + 0], P[BASE + 1]), a1 = cvtpk(P[BASE + 2], P[BASE + 3]);   \
    unsigned b0 = cvtpk(P[BASE + 4], P[BASE + 5]), b1 = cvtpk(P[BASE + 6], P[BASE + 7]);                              \
    auto r0 = __builtin_amdgcn_permlane32_swap(a0, b0, false, false); auto r1 = __builtin_amdgcn_permlane32_swap(a1, b1, false, false); \
    u32x4 w = {r0[0], r1[0], r0[1], r1[1]}; OUT = *reinterpret_cast<bf16x8*>(&w); } while (0)
  PK4(p0, 0, pa0); PK4(p0, 8, pa1); PK4(p1, 0, pa2); PK4(p1, 8, pa3);
#undef PK4
}
__device__ __forceinline__ void qkt(f32x16& p0, f32x16& p1, const bf16* Ks, const bf16x8* qr, int r32, int hi) {
  p0 = f32x16{}; p1 = f32x16{};
  for (int d0 = 0; d0 < 8; ++d0) { int cb = (d0 * 16 + hi * 8) * 2;
    bf16x8 b0 = *reinterpret_cast<const bf16x8*>((const char*)Ks + KSWZ(r32, cb));
    bf16x8 b1 = *reinterpret_cast<const bf16x8*>((const char*)Ks + KSWZ(32 + r32, cb));
    p0 = __builtin_amdgcn_mfma_f32_32x32x16_bf16(b0, qr[d0], p0, 0, 0, 0);
    p1 = __builtin_amdgcn_mfma_f32_32x32x16_bf16(b1, qr[d0], p1, 0, 0, 0); }
}
__device__ __forceinline__ int v_st(int k, int c) { const int kk = (k & ~0xC) | ((k & 4) << 1) | ((k & 8) >> 1); return ((kk >> 3) * 4 + (c >> 5)) * 512 + ((kk & 7) * 32 + (c & 31)) * 2; }
__device__ __forceinline__ int v_rd_base(int lane) { return ((lane & 3) << 3) | (((lane >> 2) & 3) << 6) | (((lane >> 4) & 1) << 5) | (((lane >> 5) & 1) << 8); }
constexpr int v_rd_off(int d0, int ks, int half) { return d0 * 512 + ks * 4096 + half * 2048; }
template <int OFF> __device__ __forceinline__ s16x4 tr_read(int vb) {
  s16x4 r; asm volatile("ds_read_b64_tr_b16 %0, %1 offset:%2" : "=&v"(r) : "v"(vb), "i"(OFF) : "memory"); return r;
}
template <int D0> __device__ __forceinline__ void pv_one(f32x16& od, int vb, bf16x8 pa0, bf16x8 pa1, bf16x8 pa2, bf16x8 pa3) {
  const s16x4 l0 = tr_read<v_rd_off(D0, 0, 0)>(vb), h0 = tr_read<v_rd_off(D0, 0, 1)>(vb), l1 = tr_read<v_rd_off(D0, 1, 0)>(vb), h1 = tr_read<v_rd_off(D0, 1, 1)>(vb);
  const s16x4 l2 = tr_read<v_rd_off(D0, 2, 0)>(vb), h2 = tr_read<v_rd_off(D0, 2, 1)>(vb), l3 = tr_read<v_rd_off(D0, 3, 0)>(vb), h3 = tr_read<v_rd_off(D0, 3, 1)>(vb);
  asm volatile("s_waitcnt lgkmcnt(0)" ::: "memory"); SBAR();
#define PK(L, H) (bf16x8){L[0], L[1], L[2], L[3], H[0], H[1], H[2], H[3]}
  od = __builtin_amdgcn_mfma_f32_32x32x16_bf16(pa0, PK(l0, h0), od, 0, 0, 0);
  od = __builtin_amdgcn_mfma_f32_32x32x16_bf16(pa1, PK(l1, h1), od, 0, 0, 0);
  od = __builtin_amdgcn_mfma_f32_32x32x16_bf16(pa2, PK(l2, h2), od, 0, 0, 0);
  od = __builtin_amdgcn_mfma_f32_32x32x16_bf16(pa3, PK(l3, h3), od, 0, 0, 0);
#undef PK
}
__device__ __forceinline__ void pv_d0(f32x16* o, int vb, bf16x8 pa0, bf16x8 pa1, bf16x8 pa2, bf16x8 pa3) {
  pv_one<0>(o[0], vb, pa0, pa1, pa2, pa3); pv_one<1>(o[1], vb, pa0, pa1, pa2, pa3); pv_one<2>(o[2], vb, pa0, pa1, pa2, pa3); pv_one<3>(o[3], vb, pa0, pa1, pa2, pa3);
}

__device__ __forceinline__ void attn_dense_body(const bf16* __restrict__ Qb, const bf16* __restrict__ Kh, const bf16* __restrict__ Vh,
                                                unsigned short* __restrict__ Ob, int seq, char* lds, const float* __restrict__ qg, int q0pos, float mC) {
  int tid = threadIdx.x; asm volatile("" : "+v"(tid));
  const int wid = tid >> 6, lane = tid & 63, r32 = lane & 31, hi = lane >> 5;
  bf16* V_lds = (bf16*)lds; bf16* K_lds = (bf16*)(lds + 2 * SHM_V);
  float* ws = (float*)(lds + 2 * SHM_V + 2 * SHM_K) + wid * 64; float* li_l = ws; float* al_l = ws + 32;
  float l_reg = 0; bf16x8 qr[8];
  const bf16* Qw = Qb + (long)(wid * QBLK + r32) * LDQ + hi * 8;
  {
    const float* qgl = qg; int hio = hi; asm volatile("" : "+s"(qgl), "+v"(hio));
#pragma unroll
    for (int d0 = 0; d0 < 8; ++d0) qr[d0] = ld8(Qw + d0 * 16);
    float ss = 0.f;
#pragma unroll
    for (int d0 = 0; d0 < 8; ++d0)
#pragma unroll
      for (int e = 0; e < 8; ++e) { const float v = __builtin_bit_cast(float, (unsigned)(unsigned short)qr[d0][e] << 16); ss += v * v; }
    { auto rr = __builtin_amdgcn_permlane32_swap(__float_as_uint(ss), __float_as_uint(ss), false, false); ss = __uint_as_float(rr[0]) + __uint_as_float(rr[1]); }
    const float rs = 1.0f / sqrtf(ss * (1.0f / 128.0f) + 1e-6f);
    const int spos = q0pos + wid * QBLK + r32;
#pragma unroll
    for (int ax = 0; ax < 2; ++ax) { const float pp = (float)(ax ? (spos & 63) : (spos >> 6));
#pragma unroll
      for (int dd = 0; dd < 2; ++dd) { const int d1 = ax * 4 + dd, d2 = d1 + 2; float o1[8], o2[8];
#pragma unroll
        for (int e = 0; e < 8; ++e) { const int j = dd * 16 + hio * 8 + e;
          const float rev = pp * (exp2f(-(float)j * 0.4152410118609203f) * 0.15915494309189535f);
          const float c = __builtin_amdgcn_cosf(rev), sn = __builtin_amdgcn_sinf(rev);
          const float x1 = __builtin_bit_cast(float, (unsigned)(unsigned short)qr[d1][e] << 16), x2 = __builtin_bit_cast(float, (unsigned)(unsigned short)qr[d2][e] << 16);
          const float y1 = x1 * rs * qgl[d1 * 16 + hio * 8 + e], y2 = x2 * rs * qgl[d2 * 16 + hio * 8 + e];
          o1[e] = y1 * c - y2 * sn; o2[e] = y2 * c + y1 * sn; }
        { u32x4 w = {cvtpk(o1[0], o1[1]), cvtpk(o1[2], o1[3]), cvtpk(o1[4], o1[5]), cvtpk(o1[6], o1[7])}; qr[d1] = *reinterpret_cast<bf16x8*>(&w); }
        { u32x4 w = {cvtpk(o2[0], o2[1]), cvtpk(o2[2], o2[3]), cvtpk(o2[4], o2[5]), cvtpk(o2[6], o2[7])}; qr[d2] = *reinterpret_cast<bf16x8*>(&w); } } }
  }
  f32x16 o[4] = {};
  const int sr = tid >> 4, sc = (tid & 15) * 8, vst0 = v_st(sr, sc), vst1 = v_st(32 + sr, sc);
  const int vb0 = (int)(uintptr_t)V_lds + v_rd_base(lane);
  struct { bf16x8 vs0, vs1, ks0, ks1; } sr_[2];
#define SLOAD(i, k0) do { sr_[i].vs0 = ld8(&Vh[(long)((k0) + sr) * LDK + sc]); sr_[i].vs1 = ld8(&Vh[(long)((k0) + 32 + sr) * LDK + sc]); \
    sr_[i].ks0 = ld8(&Kh[(long)((k0) + sr) * LDK + sc]); sr_[i].ks1 = ld8(&Kh[(long)((k0) + 32 + sr) * LDK + sc]); } while (0)
#define SWRITE(b, i) do { *(bf16x8*)((char*)V_lds + (b) * SHM_V + vst0) = sr_[i].vs0;          \
    *(bf16x8*)((char*)V_lds + (b) * SHM_V + vst1) = sr_[i].vs1; int kc = sc * 2;               \
    *(bf16x8*)((char*)K_lds + (b) * SHM_K + KSWZ(sr, kc)) = sr_[i].ks0;                       \
    *(bf16x8*)((char*)K_lds + (b) * SHM_K + KSWZ(32 + sr, kc)) = sr_[i].ks1; } while (0)
#define SWAIT() asm volatile("s_waitcnt vmcnt(4)" ::: "memory")
  f32x16 pA0, pA1, pB0, pB1; bf16x8 pa0, pa1, pa2, pa3; const int NT = seq / KVBLK;
  constexpr int SE = 0, SO = 1;
  SLOAD(SE, 0); asm volatile("s_waitcnt vmcnt(0)" ::: "memory"); SWRITE(0, SE); __syncthreads();
  qkt(pA0, pA1, K_lds, qr, r32, hi); partialSM(pA0, pA1, mC);
  SLOAD(SO, KVBLK); if (2 < NT) SLOAD(SE, 2 * KVBLK);
  SWAIT(); SWRITE(1, SO); __syncthreads();
  for (int j = 1; j + 1 < NT; j += 2) {
    SBAR(); qkt(pB0, pB1, (bf16*)((char*)K_lds + SHM_K), qr, r32, hi);
    finishSM(pA0, pA1, l_reg, pa0, pa1, pa2, pa3); SBAR();
    SLOAD(SO, (j + 2) * KVBLK); SBAR();
    pv_d0(o, vb0, pa0, pa1, pa2, pa3); partialSM(pB0, pB1, mC);
    __syncthreads(); SWAIT(); SWRITE(0, SE);
    __syncthreads();
    SBAR(); qkt(pA0, pA1, K_lds, qr, r32, hi);
    finishSM(pB0, pB1, l_reg, pa0, pa1, pa2, pa3); SBAR();
    if (j + 3 < NT) SLOAD(SE, (j + 3) * KVBLK); SBAR();
    pv_d0(o, vb0 + (int)SHM_V, pa0, pa1, pa2, pa3); partialSM(pA0, pA1, mC);
    __syncthreads(); SWAIT(); SWRITE(1, SO);
    __syncthreads();
  }
  SBAR(); qkt(pB0, pB1, (bf16*)((char*)K_lds + SHM_K), qr, r32, hi);
  finishSM(pA0, pA1, l_reg, pa0, pa1, pa2, pa3); SBAR();
  pv_d0(o, vb0, pa0, pa1, pa2, pa3); partialSM(pB0, pB1, mC);
  __syncthreads();
  finishSM(pB0, pB1, l_reg, pa0, pa1, pa2, pa3); SBAR();
  pv_d0(o, vb0 + (int)SHM_V, pa0, pa1, pa2, pa3);
  if (hi == 0) li_l[r32] = l_reg; asm volatile("s_waitcnt lgkmcnt(0)" ::: "memory");
  float rli[16];
#pragma unroll
  for (int r = 0; r < 16; ++r) rli[r] = __builtin_amdgcn_rcpf(li_l[crow(r, hi)]);
  unsigned short* Ow = Ob + (long)(wid * QBLK) * LDO;
#pragma unroll
  for (int r = 0; r < 16; ++r) { int orow = crow(r, hi);
    for (int d0 = 0; d0 < 4; ++d0) Ow[(long)orow * LDO + d0 * 32 + r32] = (unsigned short)(cvtpk(o[d0][r] * rli[r], 0.f) & 0xffffu); }
  __syncthreads();
#undef SLOAD
#undef SWRITE
#undef SWAIT
}
}

#define LAS __attribute__((address_space(3)))
typedef unsigned short bf16_t;
typedef float f32x4 __attribute__((ext_vector_type(4)));
typedef unsigned v4u __attribute__((ext_vector_type(4)));
typedef unsigned v2u __attribute__((ext_vector_type(2)));
constexpr size_t MiB = 1u << 20;
constexpr size_t WS_WOUT = 1 * MiB, WS_WQKV = 3 * MiB, WS_WO = 6 * MiB, WS_WUP = 8 * MiB, WS_WDN = 24 * MiB, WS_WC = 40 * MiB, WS_FA = 40 * MiB + 65536, WS_FB = 41 * MiB, WS_SSQ = 42 * MiB  ;
constexpr size_t WS_R1 = 48 * MiB;
constexpr size_t WS_R2 = 240 * MiB;
constexpr size_t WS_YT = WS_R2 + 384 * MiB;
constexpr size_t WS_END = WS_R2 + 768 * MiB;
constexpr int LDS_BYTES = 131072 + 4096;
constexpr int N_PHASES = 14;

__device__ __forceinline__ unsigned f2bf(float f) { unsigned u = __builtin_bit_cast(unsigned, f); return (u + 0x7fffu + ((u >> 16) & 1u)) >> 16; }
__device__ __forceinline__ unsigned pk2(float lo, float hi) { return f2bf(lo) | (f2bf(hi) << 16); }
__device__ __forceinline__ float bf2f(unsigned short b) { return __builtin_bit_cast(float, (unsigned)b << 16); }
__device__ __forceinline__ float wave_sum(float v) {
#pragma unroll
    for (int o = 1; o < 64; o <<= 1) v += __shfl_xor(v, o);
    return v;
}
__device__ __forceinline__ void transpose_item(const float* W, int K, int N, bf16_t* WT, LAS float* scr, int item, int lane, const float* gain = nullptr) {
    const int nblk = N / 32, kb = item / nblk, nb = item % nblk, k0 = 64 * kb, n0 = 32 * nb;
#pragma unroll 8
    for (int i = 0; i < 32; ++i) { const int kk = 2 * i + (lane >> 5); const float gk = gain ? gain[k0 + kk] : 1.0f; scr[kk * 33 + (lane & 31)] = W[(size_t)(k0 + kk) * N + n0 + (lane & 31)] * gk; }
    asm volatile("s_waitcnt lgkmcnt(0)" ::: "memory");
    const int c = lane & 7;
#pragma unroll
    for (int j = 0; j < 4; ++j) { const int n = (lane >> 3) + 8 * j; const LAS float* s = scr + (8 * c) * 33 + n;
        v4u o; o.x = pk2(s[0 * 33], s[1 * 33]); o.y = pk2(s[2 * 33], s[3 * 33]); o.z = pk2(s[4 * 33], s[5 * 33]); o.w = pk2(s[6 * 33], s[7 * 33]);
        *(v4u*)(WT + (size_t)(n0 + n) * K + k0 + 8 * c) = o; }
    asm volatile("s_waitcnt lgkmcnt(0)" ::: "memory");
}
__device__ __forceinline__ void rms_rows_bf16(const float* x0, const float* x1, const float* g, bf16_t* out, int gw, int NGW, int ln) {
    f32x4 gv[4];
#pragma unroll
    for (int j = 0; j < 4; ++j) gv[j] = ((const f32x4*)g)[ln + 64 * j];
    for (int m = gw * 4; m < T; m += NGW * 4) {
        const float* xr = (m < T_PROMPT) ? x0 + (size_t)m * D : x1 + (size_t)(m - T_PROMPT) * D;
        f32x4 v[4][4];
#pragma unroll
        for (int r = 0; r < 4; ++r)
#pragma unroll
            for (int j = 0; j < 4; ++j) v[r][j] = ((const f32x4*)(xr + r * D))[ln + 64 * j];
#pragma unroll
        for (int r = 0; r < 4; ++r) { float s = 0.f;
#pragma unroll
            for (int j = 0; j < 4; ++j) s += (v[r][j].x * v[r][j].x + v[r][j].y * v[r][j].y) + (v[r][j].z * v[r][j].z + v[r][j].w * v[r][j].w);
            const float rs = 1.0f / sqrtf(wave_sum(s) * (1.0f / D) + EPS);
            v2u* o8 = (v2u*)(out + (size_t)(m + r) * D) + ln;
#pragma unroll
            for (int j = 0; j < 4; ++j) { const f32x4 y = v[r][j] * rs * gv[j]; v2u w; w.x = pk2(y.x, y.y); w.y = pk2(y.z, y.w); o8[64 * j] = w; } }
    }
}
__device__ __forceinline__ void rms_rows_final(const bf16_t* xs, const float* g, float* o, int gw, int NGW, int ln) {
    f32x4 gv[2][2];
#pragma unroll
    for (int j = 0; j < 2; ++j) { gv[j][0] = ((const f32x4*)g)[2 * ln + 128 * j]; gv[j][1] = ((const f32x4*)g)[2 * ln + 128 * j + 1]; }
    for (int m = gw * 4; m < T; m += NGW * 4) {
        v4u raw[4][2];
#pragma unroll
        for (int r = 0; r < 4; ++r)
#pragma unroll
            for (int j = 0; j < 2; ++j) raw[r][j] = ((const v4u*)(xs + (size_t)(m + r) * D))[ln + 64 * j];
#pragma unroll
        for (int r = 0; r < 4; ++r) { float x[2][8]; float sq = 0.f;
#pragma unroll
            for (int j = 0; j < 2; ++j)
#pragma unroll
                for (int e = 0; e < 4; ++e) { x[j][2 * e] = __builtin_bit_cast(float, raw[r][j][e] << 16); x[j][2 * e + 1] = __builtin_bit_cast(float, raw[r][j][e] & 0xffff0000u); sq += x[j][2 * e] * x[j][2 * e] + x[j][2 * e + 1] * x[j][2 * e + 1]; }
            const float rs = 1.0f / sqrtf(wave_sum(sq) * (1.0f / D) + EPS);
            f32x4* orow = (f32x4*)(o + (size_t)(m + r) * D);
#pragma unroll
            for (int j = 0; j < 2; ++j) { orow[2 * ln + 128 * j] = (f32x4){x[j][0], x[j][1], x[j][2], x[j][3]} * rs * gv[j][0]; orow[2 * ln + 128 * j + 1] = (f32x4){x[j][4], x[j][5], x[j][6], x[j][7]} * rs * gv[j][1]; } }
    }
}

#define XB_TMO      128
#define XB_XCNT(j)  (256  + 64 * (j))
#define XB_XSUB(j)  (1280 + 64 * (j))
#define XB_XGEN(j)  (2304 + 64 * (j))
#define XB_TOP      3328
#define XB_TOPGEN   3392
#define XCD_BAR_WORDS 3456
#define XB_SPIN_CAP (1u << 18)

__device__ __forceinline__ unsigned xb_ld(unsigned* p)              { return __hip_atomic_load(p, __ATOMIC_RELAXED, __HIP_MEMORY_SCOPE_AGENT); }
__device__ __forceinline__ unsigned xb_add(unsigned* p, unsigned v) { return __hip_atomic_fetch_add(p, v, __ATOMIC_RELAXED, __HIP_MEMORY_SCOPE_AGENT); }
__device__ __forceinline__ unsigned xb_xcc_id() { return (unsigned)__builtin_amdgcn_s_getreg((3 << 11) | 20) & 0xFu; }
#define XB_SPIN(cond, bar) do { unsigned _sp = 0; while (cond) { __builtin_amdgcn_s_sleep(1); \
    if ((++_sp & 255u) == 0u) { if (xb_ld(&(bar)[XB_TMO])) break; if (_sp > XB_SPIN_CAP) { atomicAdd(&(bar)[XB_TMO], 1u); break; } } } } while (0)

struct XcdBarrier {
    unsigned* bar; unsigned x;
    volatile LAS unsigned* st;
};

__device__ __forceinline__ XcdBarrier xcd_barrier_post(unsigned* bar, volatile LAS unsigned* st) {
    XcdBarrier b; b.bar = bar; b.x = xb_xcc_id(); b.st = st;
    if (threadIdx.x == 0) (void)xb_add(&bar[XB_XCNT(b.x)], 1u);
    return b;
}
__device__ __forceinline__ void xcd_barrier_complete(unsigned* bar, unsigned x, unsigned& nloc, unsigned& nx) {
    const unsigned G = gridDim.x * gridDim.y * gridDim.z;
    unsigned sum, cnt, mine, sp = 0u;
    for (;;) {
        sum = 0u; cnt = 0u; mine = 0u;
#pragma unroll
        for (unsigned j = 0; j < 16; ++j) { const unsigned c = xb_ld(&bar[XB_XCNT(j)]); sum += c; cnt += (c > 0u) ? 1u : 0u; mine = (j == x) ? c : mine; }
        if (sum == G) break;
        __builtin_amdgcn_s_sleep(1);
        if ((++sp & 255u) == 0u) { if (xb_ld(&bar[XB_TMO])) break; if (sp > XB_SPIN_CAP) { atomicAdd(&bar[XB_TMO], 1u); break; } }
    }
    nloc = mine > 0u ? mine : 1u; nx = cnt > 0u ? cnt : 1u;
}

__device__ __forceinline__ void xcd_barrier(const XcdBarrier& b) {
    asm volatile("s_waitcnt vmcnt(0)" ::: "memory");
    __syncthreads();
    if (threadIdx.x == 0) {
        unsigned* bar = b.bar;
        __builtin_amdgcn_s_waitcnt(0);
        unsigned nloc = b.st[0], nx = b.st[1];
        if (nloc == 0u) { xcd_barrier_complete(bar, b.x, nloc, nx); b.st[0] = nloc; b.st[1] = nx; }
        const unsigned old = xb_add(&bar[XB_XSUB(b.x)], 1u);
        const unsigned gen = old / nloc;
        if (old + 1u == (gen + 1u) * nloc) {
            __builtin_amdgcn_fence(__ATOMIC_RELEASE, "agent");
            asm volatile("s_waitcnt vmcnt(0)" ::: "memory");
            const unsigned og = xb_add(&bar[XB_TOP], 1u);
            const unsigned tg = og / nx;
            if (og + 1u == (tg + 1u) * nx) xb_add(&bar[XB_TOPGEN], 1u);
            else XB_SPIN(xb_ld(&bar[XB_TOPGEN]) == tg, bar);
            __builtin_amdgcn_fence(__ATOMIC_ACQUIRE, "agent");
            xb_add(&bar[XB_XGEN(b.x)], 1u);
            asm volatile("s_waitcnt vmcnt(0)" ::: "memory");
        } else {
            XB_SPIN(xb_ld(&bar[XB_XGEN(b.x)]) == gen, bar);
            __builtin_amdgcn_fence(__ATOMIC_ACQUIRE, "agent");
            asm volatile("s_waitcnt vmcnt(0)" ::: "memory");
        }
    }
    __syncthreads();
}

struct Args { const float* in[13]; float* out; unsigned char* ws; int ph_lo, ph_hi; };

__global__ void __launch_bounds__(512, 2) fwd_megakernel(Args args) {
    extern __shared__ __attribute__((aligned(16))) unsigned char lds[];
#define TIDX ({ int t_ = threadIdx.x; asm volatile("" : "+v"(t_)); t_; })
#define tid TIDX
#define lane (TIDX & 63)
    const int wave = __builtin_amdgcn_readfirstlane(TIDX >> 6);
    const int G = gridDim.x, cb = blockIdx.x;
    const int gw = cb * 8 + wave, NGW = G * 8;
    unsigned char* ws = args.ws;
    const float* x_prompt = args.in[0]; const float* x_sample = args.in[1];
    const float* fourier_norm = args.in[2]; const float* fourier_w_out = args.in[3];
    const float* attn_norm = args.in[4]; const float* attn_w_qkv = args.in[5]; const float* q_gain = args.in[6]; const float* k_gain = args.in[7];
    const float* attn_w_o = args.in[8]; const float* mlp_norm = args.in[9]; const float* mlp_w_up = args.in[10]; const float* mlp_w_down = args.in[11]; const float* final_norm = args.in[12];
    float* out = args.out;
    bf16_t* WoutT = (bf16_t*)(ws + WS_WOUT); bf16_t* WqkvT = (bf16_t*)(ws + WS_WQKV); bf16_t* WoT = (bf16_t*)(ws + WS_WO);
    bf16_t* WupT = (bf16_t*)(ws + WS_WUP); bf16_t* WdnT = (bf16_t*)(ws + WS_WDN); bf16_t* Wc = (bf16_t*)(ws + WS_WC);
    bf16_t* R1 = (bf16_t*)(ws + WS_R1); bf16_t* R2 = (bf16_t*)(ws + WS_R2); bf16_t* YT = (bf16_t*)(ws + WS_YT); bf16_t* FA = (bf16_t*)(ws + WS_FA); bf16_t* FB = (bf16_t*)(ws + WS_FB); float* SSQ = (float*)(ws + WS_SSQ); bf16_t* OB = YT;
    PG8_LAS unsigned char* glds = (PG8_LAS unsigned char*)lds;
    const int lo = args.ph_lo, hi = args.ph_hi;
    volatile LAS unsigned* MISC = (volatile LAS unsigned*)((LAS unsigned char*)lds + 131072);
    if (tid < 16) MISC[tid] = 0u;
    __syncthreads();
    if (hi > 1000) cg::this_grid().sync();
    XcdBarrier xbar = xcd_barrier_post((unsigned*)ws, MISC + 8);
    int ph = 0;
#define PH_ON (lo <= ph && ph < hi)
#define PH_NEXT do { if (lo <= ph && ph + 1 < hi) xcd_barrier(xbar); ++ph; } while (0)

    if (PH_ON) {
        const long gtid = (long)cb * 512 + tid, NTH = (long)G * 512;
        LAS float* scr = (LAS float*)((LAS unsigned char*)lds + wave * 16384);
        constexpr int I_SQ = (D / 64) * (D / 32), I_QKV = (D / 64) * (QKVD / 32), I_UP = (D / 64) * (FF / 32), I_DN = (FF / 64) * (D / 32);
        constexpr int NITEMS = 2 * I_SQ + I_QKV + 2 * I_UP + 2 * I_DN;
        for (int it = gw; it < NITEMS; it += NGW) {
            int r = it;
            if (r < I_SQ) { transpose_item(fourier_w_out, D, D, WoutT, scr, r, lane); continue; } r -= I_SQ;
            if (r < I_SQ) { transpose_item(attn_w_o, D, D, WoT, scr, r, lane); continue; } r -= I_SQ;
            if (r < I_QKV) { transpose_item(attn_w_qkv, D, QKVD, WqkvT, scr, r, lane, attn_norm); continue; } r -= I_QKV;
            if (r < I_UP) { transpose_item(mlp_w_up, D, FF, WupT, scr, r, lane, mlp_norm); continue; } r -= I_UP;
            if (r < I_UP) { transpose_item(mlp_w_up + (size_t)D * FF, D, FF, WupT + (size_t)D * FF, scr, r, lane, mlp_norm + D); continue; } r -= I_UP;
            if (r < I_DN) { transpose_item(mlp_w_down, FF, D, WdnT, scr, r, lane); continue; } r -= I_DN;
            transpose_item(mlp_w_down + (size_t)D * FF, FF, D, WdnT + (size_t)D * FF, scr, r, lane);
        }
        for (long it = gtid; it < 256 * 128 / 8; it += NTH) {
            const int row = (int)(it >> 4), c0 = (int)(it & 15) * 8, l = row >> 1, ri = row & 1; float v[8];
#pragma unroll
            for (int e = 0; e < 8; ++e) { const float ang = (float)((l * (c0 + e)) & 127) * (1.0f / 64.0f); v[e] = ri ? -sinpif(ang) : cospif(ang); }
            v4u o; o.x = pk2(v[0], v[1]); o.y = pk2(v[2], v[3]); o.z = pk2(v[4], v[5]); o.w = pk2(v[6], v[7]);
            *(v4u*)(Wc + (size_t)row * 128 + c0) = o;
        }
        for (long it = gtid; it < 128 * 128 / 8; it += NTH) {
            const int row = (int)(it >> 4), c0 = (int)(it & 15) * 8, k1 = row >> 1, ro = row & 1, ri = c0 >> 6; float v[8];
#pragma unroll
            for (int e = 0; e < 8; ++e) { const int s1 = (c0 + e) & 63; const float ang = (float)((k1 * s1) & 63) * (1.0f / 32.0f); const float cv = cospif(ang), sv = sinpif(ang);
                v[e] = (ro == ri) ? cv : (ro ? -sv : sv); }
            v4u o; o.x = pk2(v[0], v[1]); o.y = pk2(v[2], v[3]); o.z = pk2(v[4], v[5]); o.w = pk2(v[6], v[7]);
            *(v4u*)(FA + (size_t)row * 128 + c0) = o;
        }
        const float sc = 0.0013810679320049757f;
        for (long it = gtid; it < 64L * 64 * 128 / 8; it += NTH) {
            const int row = (int)(it >> 4), c0 = (int)(it & 15) * 8, k1 = row >> 6, k2 = row & 63, ro = c0 >> 6; float v[8];
#pragma unroll
            for (int e = 0; e < 8; ++e) { const int s2 = (c0 + e) & 63; const float ang = (float)(((k1 + 64 * k2) * s2) & 4095) * (1.0f / 2048.0f); v[e] = (ro ? sinpif(ang) : cospif(ang)) * sc; }
            v4u o; o.x = pk2(v[0], v[1]); o.y = pk2(v[2], v[3]); o.z = pk2(v[4], v[5]); o.w = pk2(v[6], v[7]);
            *(v4u*)(FB + (size_t)row * 128 + c0) = o;
        }
        for (long it = gtid; it < 4L * T / 4; it += NTH) ((f32x4*)SSQ)[it] = (f32x4){0.f, 0.f, 0.f, 0.f};
        rms_rows_bf16(x_prompt, x_sample, fourier_norm, R1, gw, NGW, lane);
    }
    PH_NEXT;
    if (PH_ON) {
        int kk = 128; asm volatile("" : "+s"(kk));
        pg8::Gemm g{kk, 128, D, 128 * 128 * 2, 2 * D * 2, 127, 1, 0}; pg8::SchedChan S{(const char*)Wc, (const char*)R1, G, cb};
        pg8::EpiChan E{R2};
        pg8::gemm_phase(glds, g, S, E);
    }
    PH_NEXT;
    if (PH_ON) {
        int kk = 128; asm volatile("" : "+s"(kk));
        pg8::Gemm g{kk, 128, 128, 0, 128 * 128 * 2, 127, 0, 1}; pg8::SchedLin S{(const char*)FA, (const char*)R2, G, cb, NBATCH * 8 * 128 * 64 / 256, 0, 0};
        pg8::EpiStageA E{YT};
        pg8::gemm_phase(glds, g, S, E);
    }
    PH_NEXT;
    if (PH_ON) {
        int kk = 128; asm volatile("" : "+s"(kk));
        pg8::Gemm g{kk, 128, 128, 0, 128 * 128 * 2, 63, 0, 2}; pg8::SchedLin S{(const char*)FB, (const char*)YT, G, cb, NBATCH * 64 * 8 * 128 / 256, 1, (size_t)64 * 128 * 2};
        pg8::EpiStageB E{R2};
        pg8::gemm_phase(glds, g, S, E);
    }
    PH_NEXT;
    if (PH_ON) {
        pg8::Gemm g = pg8::plain(D, D, D); pg8::SchedMN S{(const char*)R2, (const char*)WoutT, T / 256, D / 256, G, cb, (size_t)256 * D * 2, (size_t)256 * D * 2, D};
        pg8::EpiRes E{x_prompt, x_sample, T_PROMPT / 256, (size_t)T_PROMPT * D, R1, SSQ, D};
        pg8::gemm_phase(glds, g, S, E);
    }
    PH_NEXT;
    if (PH_ON) {
        pg8::Gemm g = pg8::plain(D, D, D); pg8::SchedMN S{(const char*)R1, (const char*)WupT, T / 256, FF / 256, G, cb, (size_t)256 * D * 2, (size_t)256 * D * 2, FF};
        pg8::EpiBf16<2> E{R2, FF, SSQ};
        pg8::gemm_phase(glds, g, S, E);
    }
    PH_NEXT;
    if (PH_ON) {
        pg8::Gemm g = pg8::plain(FF, FF, FF); pg8::SchedMN S{(const char*)R2, (const char*)WdnT, T / 256, D / 256, G, cb, (size_t)256 * FF * 2, (size_t)256 * FF * 2, D};
        pg8::EpiRes E{nullptr, nullptr, 0, 0, R1, SSQ + T, D};
        pg8::gemm_phase(glds, g, S, E);
    }
    PH_NEXT;
    if (PH_ON) {
        pg8::Gemm g = pg8::plain(D, D, D); pg8::SchedMN S{(const char*)R1, (const char*)WqkvT, T / 256, QKVD / 256, G, cb, (size_t)256 * D * 2, (size_t)256 * D * 2, QKVD};
        pg8::EpiBf16<0> E{R2, QKVD, SSQ + T};
        pg8::gemm_phase(glds, g, S, E);
    }
    PH_NEXT;
    if (PH_ON) {
        const int hs = lane >> 4, i16 = lane & 15, axis = i16 >> 3, x2half = (i16 >> 2) & 1, j0 = (i16 & 3) * 8;
        float inv[8], gk[8];
#pragma unroll
        for (int e = 0; e < 8; ++e) { inv[e] = exp2f(-(float)(2 * (j0 + e)) * (1.0f / 64.0f) * 13.287712379549449f) * 0.15915494309189535f;
            gk[e] = k_gain[i16 * 8 + e]; }
        for (int t0 = gw * 8; t0 < T; t0 += NGW * 8) {
            v4u raw[4];
#pragma unroll
            for (int u = 0; u < 4; ++u) raw[u] = *(const v4u*)(R2 + (size_t)(t0 + 2 * u + (hs >> 1)) * QKVD + 1024 + (hs & 1) * 128 + i16 * 8);
#pragma unroll
            for (int u = 0; u < 4; ++u) {
                const int t = t0 + 2 * u + (hs >> 1), sp = t & (SEQ - 1); const float p = (float)(axis ? (sp & 63) : (sp >> 6));
                float x[8];
#pragma unroll
                for (int e = 0; e < 4; ++e) { x[2 * e] = __builtin_bit_cast(float, raw[u][e] << 16); x[2 * e + 1] = __builtin_bit_cast(float, raw[u][e] & 0xffff0000u); }
                float ss = 0.f;
#pragma unroll
                for (int e = 0; e < 8; ++e) ss += x[e] * x[e];
                ss += __shfl_xor(ss, 1); ss += __shfl_xor(ss, 2); ss += __shfl_xor(ss, 4); ss += __shfl_xor(ss, 8);
                const float rs = 1.0f / sqrtf(ss * (1.0f / 128.0f) + EPS);
                float o[8];
#pragma unroll
                for (int e = 0; e < 8; ++e) { const float rev = p * inv[e]; const float cs = __builtin_amdgcn_cosf(rev); float sn = __builtin_amdgcn_sinf(rev); if (!x2half) sn = -sn;
                    const float y = x[e] * rs * gk[e]; const float pr = __shfl_xor(y, 4); o[e] = y * cs + pr * sn; }
                v4u w; w.x = pk2(o[0], o[1]); w.y = pk2(o[2], o[3]); w.z = pk2(o[4], o[5]); w.w = pk2(o[6], o[7]);
                *(v4u*)(R2 + (size_t)t * QKVD + 1024 + (hs & 1) * 128 + i16 * 8) = w;
            }
        }
    }
    PH_NEXT;
    if (PH_ON) {
        const int rounds = (NBATCH * 8 * 16 + G - 1) / G;
        float gqm = fmaxf(fabsf(q_gain[lane]), fabsf(q_gain[lane + 64])), gkm = fmaxf(fabsf(k_gain[lane]), fabsf(k_gain[lane + 64]));
#pragma unroll
        for (int o_ = 1; o_ < 64; o_ <<= 1) { gqm = fmaxf(gqm, __shfl_xor(gqm, o_)); gkm = fmaxf(gkm, __shfl_xor(gkm, o_)); }
        const float mC = -(128.0f * gqm * gkm * 1.02f) * (attn::SCALE * 1.4426950408889634f);
        for (int i = 0; i < rounds; ++i) {
            int b, h, qb;
            if (G == 256) { const int x = cb & 7, sl = cb >> 3; b = 2 * i + (x >> 2); const int kvh = (x >> 1) & 1; h = kvh * 4 + (x & 1) * 2 + (sl >> 4); qb = sl & 15; }
            else { const int u = i * G + cb; if (u >= NBATCH * 8 * 16) break; b = u >> 7; h = (u >> 4) & 7; qb = u & 15; }
            const int kvh = h >> 2;
            const attn::bf16* base = (const attn::bf16*)R2 + (size_t)b * SEQ * QKVD;
            attn::attn_dense_body(base + (size_t)qb * 256 * QKVD + h * 128, base + 1024 + kvh * 128, base + 1280 + kvh * 128,
                                  OB + ((size_t)b * SEQ + (size_t)qb * 256) * D + h * 128, SEQ, (char*)lds, q_gain, qb * 256, mC);
        }
    }
    PH_NEXT;
    if (PH_ON) {
        pg8::Gemm g = pg8::plain(D, D, D); pg8::SchedMN S{(const char*)OB, (const char*)WoT, T / 256, D / 256, G, cb, (size_t)256 * D * 2, (size_t)256 * D * 2, D};
        pg8::EpiRes E{nullptr, nullptr, 0, 0, R1, SSQ + 2 * T, D};
        pg8::gemm_phase(glds, g, S, E);
    }
    PH_NEXT;
    if (PH_ON) {
        pg8::Gemm g = pg8::plain(D, D, D); pg8::SchedMN S{(const char*)R1, (const char*)(WupT + (size_t)D * FF), T / 256, FF / 256, G, cb, (size_t)256 * D * 2, (size_t)256 * D * 2, FF};
        pg8::EpiBf16<2> E{R2, FF, SSQ + 2 * T};
        pg8::gemm_phase(glds, g, S, E);
    }
    PH_NEXT;
    if (PH_ON) {
        pg8::Gemm g = pg8::plain(FF, FF, FF); pg8::SchedMN S{(const char*)R2, (const char*)(WdnT + (size_t)D * FF), T / 256, D / 256, G, cb, (size_t)256 * FF * 2, (size_t)256 * FF * 2, D};
        pg8::EpiRes E{nullptr, nullptr, 0, 0, R1, SSQ + 3 * T, D};
        pg8::gemm_phase(glds, g, S, E);
    }
    PH_NEXT;
    if (PH_ON) rms_rows_final(R1, final_norm, out, gw, NGW, lane);
#undef PH_ON
#undef PH_NEXT
#undef tid
#undef lane
}

extern "C" void kernel_launch(void* const* d_in, const int* in_sizes, int n_in, void* d_out, int out_size, void* d_ws, size_t ws_size, hipStream_t stream) {
    static int grid = 0;
    if (grid == 0) {
        if (n_in != 13 || out_size != T * D || ws_size < WS_END) { fprintf(stderr, "kernel_launch: shape/workspace mismatch (n_in %d out %d ws %zu, need %zu)\n", n_in, out_size, ws_size, (size_t)WS_END); grid = -1; return; }
        int dev = 0, cus = 0, per_cu = 0;
        if (hipGetDevice(&dev) != hipSuccess || hipDeviceGetAttribute(&cus, hipDeviceAttributeMultiprocessorCount, dev) != hipSuccess) { grid = -1; return; }
        if (hipFuncSetAttribute((const void*)fwd_megakernel, hipFuncAttributeMaxDynamicSharedMemorySize, LDS_BYTES) != hipSuccess) { fprintf(stderr, "kernel_launch: hipFuncSetAttribute failed\n"); grid = -1; return; }
        if (hipOccupancyMaxActiveBlocksPerMultiprocessor(&per_cu, (const void*)fwd_megakernel, 512, LDS_BYTES) != hipSuccess || per_cu < 1) { fprintf(stderr, "kernel_launch: occupancy query says %d\n", per_cu); per_cu = 1; }
        (void)hipGetLastError();
        grid = cus;
    }
    if (grid < 0) return;
    (void)hipMemsetAsync(d_ws, 0, 16384, stream);
    Args a{};
    for (int i = 0; i < 13; ++i) a.in[i] = (const float*)d_in[i];
    a.out = (float*)d_out; a.ws = (unsigned char*)d_ws;
#if MK_PER_PHASE
    for (int p = 0; p < N_PHASES; ++p) { a.ph_lo = p; a.ph_hi = p + 1; hipLaunchKernelGGL(fwd_megakernel, dim3(grid), dim3(512), LDS_BYTES, stream, a); }
#else
    a.ph_lo = 0; a.ph_hi = N_PHASES;
    void* kargs[] = {&a};
    hipError_t e = hipLaunchCooperativeKernel((const void*)fwd_megakernel, dim3(grid), dim3(512), kargs, LDS_BYTES, stream);
    if (e != hipSuccess) fprintf(stderr, "kernel_launch: cooperative launch failed: %s (grid %d)\n", hipGetErrorString(e), grid);
#endif
}
```
